# Optimizing an MI355X kernel written in HIP

```python
import math
import jax, jax.numpy as jnp
from jax import lax
import numpy as np

D_MODEL = 1024
BATCH = 1
SEQ = 16384
DEPTH = 1
DEC_BATCH = 2
DEC_SEQ = 8192
PAST_LEN = 128

CONV_WIDTH = 512
CONV_KERNEL = 31
N_HEADS = 4
HEAD_DIM = 64
V_DIM = 2 * HEAD_DIM
ATTN_WIDTH = N_HEADS * V_DIM
QK_WIDTH = N_HEADS * 2 * HEAD_DIM
ROPE_THETA = 10000.0
Q_BLOCK = 128
ALPHA = (2.0 * DEPTH) ** 0.25
BETA = (8.0 * DEPTH) ** -0.25
LN_EPS = 1e-5

SPLIT_SIZES = (CONV_WIDTH, CONV_WIDTH, CONV_WIDTH,
               QK_WIDTH, QK_WIDTH, ATTN_WIDTH,
               ATTN_WIDTH,
               D_MODEL, D_MODEL)
IN_WIDTH = sum(SPLIT_SIZES)
SPLIT_POINTS = tuple(int(v) for v in np.cumsum(SPLIT_SIZES)[:-1])

kernel_name = "hybrid_conformer_diffattn_encoder"


def layer_norm(x, g, b):
    xf = x.astype(jnp.float32)
    mu = jnp.mean(xf, axis=-1, keepdims=True)
    var = jnp.mean(jnp.square(xf - mu), axis=-1, keepdims=True)
    y = (xf - mu) * lax.rsqrt(var + LN_EPS) * g.astype(jnp.float32) + b.astype(jnp.float32)
    return y.astype(x.dtype)


def rms_norm(x, g):
    xf = x.astype(jnp.float32)
    y = xf * lax.rsqrt(jnp.mean(jnp.square(xf), axis=-1, keepdims=True) + LN_EPS) * g.astype(jnp.float32)
    return y.astype(x.dtype)


def apply_rope(t):
    S = t.shape[1]
    pos = jnp.arange(S, dtype=jnp.float32)
    inv_freq = 1.0 / jnp.power(ROPE_THETA, jnp.arange(0, HEAD_DIM, 2, dtype=jnp.float32) / HEAD_DIM)
    ang = pos[:, None] * inv_freq[None, :]
    cos = jnp.concatenate([jnp.cos(ang), jnp.cos(ang)], axis=-1)[None, :, None, None, :]
    sin = jnp.concatenate([jnp.sin(ang), jnp.sin(ang)], axis=-1)[None, :, None, None, :]
    tf = t.astype(jnp.float32)
    t1, t2 = jnp.split(tf, 2, axis=-1)
    rot = jnp.concatenate([-t2, t1], axis=-1)
    return (tf * cos + rot * sin).astype(t.dtype)


def diff_attention(q, k, v, lam):
    B, S = q.shape[0], q.shape[1]
    n_blk = S // Q_BLOCK
    qb = q.reshape(B, n_blk, Q_BLOCK, N_HEADS, 2, HEAD_DIM).transpose(1, 0, 2, 3, 4, 5)
    scale = 1.0 / math.sqrt(HEAD_DIM)

    def block(q_blk):
        s = jnp.einsum('bqhcd,bkhcd->bhcqk', q_blk, k).astype(jnp.float32) * scale
        p = jax.nn.softmax(s, axis=-1)
        a = p[:, :, 0] - lam * p[:, :, 1]
        return jnp.einsum('bhqk,bkhe->bqhe', a.astype(v.dtype), v)

    out = lax.map(block, qb)
    return out.transpose(1, 0, 2, 3, 4).reshape(B, S, N_HEADS, V_DIM)


def encoder_layer(x, w_in, b_in, conv_dw, conv_dw_b, conv_ln_g, conv_ln_b, w_conv_proj, b_conv_proj,
                  lam_q1, lam_k1, lam_q2, lam_k2, subln_g, w_attn_o, w_out, b_out, ln_g, ln_b, lam_init):
    B, S, _ = x.shape
    h = x @ w_in + b_in
    glu_a, glu_b, conv_gate, q, k, v, attn_gate, m_conv, m_attn = jnp.split(h, SPLIT_POINTS, axis=-1)

    u = glu_a * jax.nn.sigmoid(glu_b)
    u = lax.conv_general_dilated(u, conv_dw[:, None, :].astype(u.dtype), window_strides=(1,),
                                 padding=[((CONV_KERNEL - 1) // 2, (CONV_KERNEL - 1) // 2)],
                                 dimension_numbers=('NWC', 'WIO', 'NWC'),
                                 feature_group_count=CONV_WIDTH) + conv_dw_b
    u = jax.nn.silu(layer_norm(u, conv_ln_g, conv_ln_b)) * jax.nn.silu(conv_gate)
    y_conv = u @ w_conv_proj + b_conv_proj

    q = apply_rope(q.reshape(B, S, N_HEADS, 2, HEAD_DIM))
    k = apply_rope(k.reshape(B, S, N_HEADS, 2, HEAD_DIM))
    v = v.reshape(B, S, N_HEADS, V_DIM)
    lam = (jnp.exp(jnp.sum(lam_q1.astype(jnp.float32) * lam_k1.astype(jnp.float32)))
           - jnp.exp(jnp.sum(lam_q2.astype(jnp.float32) * lam_k2.astype(jnp.float32))) + lam_init)
    o = diff_attention(q, k, v, lam)
    o = rms_norm(o, subln_g) * (1.0 - lam_init)
    o = o.reshape(B, S, ATTN_WIDTH) * jax.nn.silu(attn_gate)
    y_attn = o @ w_attn_o

    merged = jax.nn.sigmoid(m_conv) * y_conv + jax.nn.sigmoid(m_attn) * y_attn
    out = merged @ w_out + b_out
    return layer_norm(ALPHA * x + out, ln_g, ln_b)


def setup_inputs(seed: int = 0) -> dict:
    key = jax.random.key(seed)
    ks = jax.random.split(key, 24)
    f32 = jnp.float32
    nrm = lambda k, shape, s: jax.random.normal(k, shape, f32) * s
    x_prompt = nrm(ks[0], (BATCH, SEQ, D_MODEL), 1.0)
    x_sample = nrm(ks[1], (DEC_BATCH, DEC_SEQ, D_MODEL), 1.0)
    w_in = nrm(ks[2], (DEPTH, D_MODEL, IN_WIDTH), D_MODEL ** -0.5)
    v_lo = SPLIT_POINTS[4]
    v_hi = SPLIT_POINTS[5]
    col_scale = jnp.ones((IN_WIDTH,), f32).at[v_lo:v_hi].set(BETA)
    w_in = w_in * col_scale
    b_in = nrm(ks[3], (DEPTH, IN_WIDTH), 0.02)
    conv_dw = nrm(ks[4], (DEPTH, CONV_KERNEL, CONV_WIDTH), CONV_KERNEL ** -0.5)
    conv_dw_b = nrm(ks[5], (DEPTH, CONV_WIDTH), 0.02)
    conv_ln_g = 1.0 + nrm(ks[6], (DEPTH, CONV_WIDTH), 0.02)
    conv_ln_b = nrm(ks[7], (DEPTH, CONV_WIDTH), 0.02)
    w_conv_proj = nrm(ks[8], (DEPTH, CONV_WIDTH, D_MODEL), CONV_WIDTH ** -0.5)
    b_conv_proj = nrm(ks[9], (DEPTH, D_MODEL), 0.02)
    lam_q1 = nrm(ks[10], (DEPTH, HEAD_DIM), 0.1)
    lam_k1 = nrm(ks[11], (DEPTH, HEAD_DIM), 0.1)
    lam_q2 = nrm(ks[12], (DEPTH, HEAD_DIM), 0.1)
    lam_k2 = nrm(ks[13], (DEPTH, HEAD_DIM), 0.1)
    subln_g = 1.0 + nrm(ks[14], (DEPTH, V_DIM), 0.02)
    w_attn_o = nrm(ks[15], (DEPTH, ATTN_WIDTH, D_MODEL), ATTN_WIDTH ** -0.5)
    w_out = nrm(ks[16], (DEPTH, D_MODEL, D_MODEL), BETA * D_MODEL ** -0.5)
    b_out = nrm(ks[17], (DEPTH, D_MODEL), 0.02)
    ln_g = 1.0 + nrm(ks[18], (DEPTH, D_MODEL), 0.02)
    ln_b = nrm(ks[19], (DEPTH, D_MODEL), 0.02)
    return {"x_prompt": x_prompt, "x_sample": x_sample, "w_in": w_in, "b_in": b_in,
            "conv_dw": conv_dw, "conv_dw_b": conv_dw_b, "conv_ln_g": conv_ln_g, "conv_ln_b": conv_ln_b,
            "w_conv_proj": w_conv_proj, "b_conv_proj": b_conv_proj,
            "lam_q1": lam_q1, "lam_k1": lam_k1, "lam_q2": lam_q2, "lam_k2": lam_k2,
            "subln_g": subln_g, "w_attn_o": w_attn_o, "w_out": w_out, "b_out": b_out,
            "ln_g": ln_g, "ln_b": ln_b}


def reference(x_prompt, x_sample, w_in, b_in, conv_dw, conv_dw_b, conv_ln_g, conv_ln_b, w_conv_proj,
              b_conv_proj, lam_q1, lam_k1, lam_q2, lam_k2, subln_g, w_attn_o, w_out, b_out, ln_g, ln_b):
    y_prompt = x_prompt
    y_sample = x_sample
    for l in range(DEPTH):
        lam_init = 0.8 - 0.6 * math.exp(-0.3 * l)
        y_prompt = encoder_layer(y_prompt, w_in[l], b_in[l], conv_dw[l], conv_dw_b[l], conv_ln_g[l],
                                 conv_ln_b[l], w_conv_proj[l], b_conv_proj[l], lam_q1[l], lam_k1[l],
                                 lam_q2[l], lam_k2[l], subln_g[l], w_attn_o[l], w_out[l], b_out[l],
                                 ln_g[l], ln_b[l], lam_init)
        y_sample = encoder_layer(y_sample, w_in[l], b_in[l], conv_dw[l], conv_dw_b[l], conv_ln_g[l],
                                 conv_ln_b[l], w_conv_proj[l], b_conv_proj[l], lam_q1[l], lam_k1[l],
                                 lam_q2[l], lam_k2[l], subln_g[l], w_attn_o[l], w_out[l], b_out[l],
                                 ln_g[l], ln_b[l], lam_init)
    return (y_prompt, y_sample)
```

```cpp
#include <hip/hip_runtime.h>
#include <hip/hip_cooperative_groups.h>
#include <cstdint>
#include <cstdio>
#include <cmath>
namespace cg = cooperative_groups;

#ifndef MULTI_LAUNCH
#define MULTI_LAUNCH 0
#endif

typedef unsigned short bf16_t;
typedef short bf16x8 __attribute__((ext_vector_type(8)));
typedef short s16x4 __attribute__((ext_vector_type(4)));
typedef float f32x16 __attribute__((ext_vector_type(16)));
typedef float f32x4 __attribute__((ext_vector_type(4)));
typedef float f32x2 __attribute__((ext_vector_type(2)));
typedef unsigned u32x4 __attribute__((ext_vector_type(4)));
typedef unsigned u32x2 __attribute__((ext_vector_type(2)));

constexpr int DM = 1024, TG = 16384, NV = 5632, NTHR = 512;
constexpr float LN_EPS = 1e-5f;
constexpr float ALPHA = 1.189207115002721f;
constexpr float LAM_INIT = 0.2f;
constexpr float QSCALE = 0.125f * 1.4426950408889634f;

constexpr size_t OFF_WIN = 0;
constexpr size_t OFF_WCP = OFF_WIN + (size_t)NV * 1024 * 2;
constexpr size_t OFF_WAO = OFF_WCP + (size_t)1024 * 512 * 2;
constexpr size_t OFF_WOUT = OFF_WAO + (size_t)1024 * 512 * 2;
constexpr size_t OFF_BIASV = OFF_WOUT + (size_t)1024 * 1024 * 2;
constexpr size_t OFF_ROPE = OFF_BIASV + 32768;
constexpr size_t OFF_MISC = OFF_ROPE + (size_t)16384 * 32 * 8;
constexpr size_t OFF_XB = OFF_MISC + 256;
constexpr size_t OFF_U = OFF_XB + (size_t)TG * 1024 * 2;
constexpr size_t OFF_CG = OFF_U + (size_t)TG * 512 * 2;
constexpr size_t OFF_Q = OFF_CG + (size_t)TG * 512 * 2;
constexpr size_t OFF_K = OFF_Q + (size_t)TG * 512 * 2;
constexpr size_t OFF_V = OFF_K + (size_t)TG * 512 * 2;
constexpr size_t OFF_AG = OFF_V + (size_t)TG * 512 * 2;
constexpr size_t OFF_MC = OFF_AG + (size_t)TG * 512 * 2;
constexpr size_t OFF_MA = OFF_MC + (size_t)TG * 1024 * 2;
constexpr size_t OFF_U2 = OFF_MA + (size_t)TG * 1024 * 2;
constexpr size_t OFF_O2 = OFF_U2 + (size_t)TG * 512 * 2;
constexpr size_t OFF_BAR = OFF_O2 + (size_t)TG * 512 * 2;
constexpr size_t WS_END = OFF_BAR + 4096;
static_assert(WS_END <= (size_t)256 * 1024 * 1024, "workspace over 256 MiB");
constexpr int LDS_BYTES = 131072 + 4096;

struct Params {
  const float* x[2];
  const float *w_in, *b_in, *conv_dw, *conv_dw_b, *conv_ln_g, *conv_ln_b, *w_cp, *b_cp, *lq1, *lk1, *lq2, *lk2, *subln_g, *w_ao, *w_out, *b_out, *ln_g, *ln_b;
  float* out;
  unsigned char* ws;
  double inv_freq_pi[32];
  int ph_lo, ph_hi;
};

__device__ __forceinline__ unsigned cvtpk(float lo, float hi) {
  unsigned r; asm volatile("v_cvt_pk_bf16_f32 %0, %1, %2" : "=v"(r) : "v"(lo), "v"(hi)); return r;
}
__device__ __forceinline__ float bf2f(unsigned short b) { return __uint_as_float(((unsigned)b) << 16); }
__device__ __forceinline__ float bflo(unsigned w) { return __uint_as_float(w << 16); }
__device__ __forceinline__ float bfhi(unsigned w) { return __uint_as_float(w & 0xffff0000u); }
__device__ __forceinline__ float sigmoidf_(float x) { return __builtin_amdgcn_rcpf(1.f + __expf(-x)); }
__device__ __forceinline__ float siluf_(float x) { return x * sigmoidf_(x); }
__device__ __forceinline__ int crow(int r, int hi) { return (r & 3) + 8 * (r >> 2) + 4 * hi; }
#define SBAR() __builtin_amdgcn_sched_barrier(0)
__device__ __forceinline__ int otid() { int t = threadIdx.x; asm volatile("" : "+v"(t)); return t; }

__device__ __forceinline__ int win_actual(int v) {
  if (v < 1024) { int b = v >> 5, h = (v >> 4) & 1, r = v & 15; int ch = 16 * b + 8 * h + (r & 7); return (r < 8) ? ch : 512 + ch; }
  if (v < 1536) return v;
  if (v < 2560) { int base = (v < 2048) ? 1536 : 2048; int j = v - base; int b = j >> 5, h = (j >> 4) & 1, r = j & 15; int g = b >> 1, sub = b & 1;
    int d = 16 * sub + 8 * h + (r & 7); return base + 64 * g + d + ((r >= 8) ? 32 : 0); }
  return v;
}

__device__ __forceinline__ void cvt_batch(const Params& p, int bi) {
  const float* __restrict__ src = p.x[bi >> 2];
  bf16_t* __restrict__ dst = (bi < 4) ? (bf16_t*)(p.ws + OFF_XB) : (bf16_t*)((unsigned char*)p.out + (size_t)TG * DM * 4);
  const long gn = (long)gridDim.x * NTHR, i = (long)blockIdx.x * NTHR + threadIdx.x + (long)(bi & 3) * 4 * gn;
  f32x4 a[4], b[4];
#pragma unroll
  for (int u = 0; u < 4; ++u) { a[u] = __builtin_nontemporal_load((const f32x4*)(src + (i + u * gn) * 8)); b[u] = __builtin_nontemporal_load((const f32x4*)(src + (i + u * gn) * 8 + 4)); }
#pragma unroll
  for (int u = 0; u < 4; ++u) { u32x4 w = {cvtpk(a[u][0], a[u][1]), cvtpk(a[u][2], a[u][3]), cvtpk(b[u][0], b[u][1]), cvtpk(b[u][2], b[u][3])};
    *(u32x4*)(dst + (i + u * gn) * 8) = w; }
}
__device__ __forceinline__ void transpose_tile(const Params& p, int bi, const float* __restrict__ src, int NS, int K, bf16_t* __restrict__ dst, bool mapped, int vt, int kt, char* lds) {
  float* tl = (float*)lds;
  const int tid = threadIdx.x;
  float r[8];
  const int j = tid & 63, v = vt * 64 + j, col = mapped ? win_actual(v) : v;
#pragma unroll
  for (int i = 0; i < 8; ++i) { const int kk = (tid >> 6) + 8 * i; r[i] = src[(long)(kt * 64 + kk) * NS + col]; }
  cvt_batch(p, bi);
  __syncthreads();
#pragma unroll
  for (int i = 0; i < 8; ++i) { const int kk = (tid >> 6) + 8 * i; tl[j * 65 + kk] = r[i]; }
  __syncthreads();
  { const int jj = tid >> 3, kc = (tid & 7) * 8; const float* q = tl + jj * 65 + kc;
    u32x4 w = {cvtpk(q[0], q[1]), cvtpk(q[2], q[3]), cvtpk(q[4], q[5]), cvtpk(q[6], q[7])};
    *(u32x4*)(dst + (long)(vt * 64 + jj) * K + kt * 64 + kc) = w; }
}

__device__ __forceinline__ int vperm(int p) { return 16 * ((p >> 2) & 1) + (p & 3) + 4 * (p >> 3); }
template <int NI>
__device__ __forceinline__ void gemm_loop(const bf16_t* __restrict__ A, int lda, const bf16_t* __restrict__ B, int ldb, int KT, char* lds, f32x16 (&acc)[4][NI]) {
  constexpr int A_BYTES = 256 * 128, B_BYTES = 128 * NI * 128, STAGE = A_BYTES + B_BYTES;
  const int tid = otid(), wid = tid >> 6, lane = tid & 63, wr = wid >> 2, wc = wid & 3, r32 = lane & 31, hi = lane >> 5;
  const int wbase_ = __builtin_amdgcn_readfirstlane(wid) * 64;
  const bf16_t* ga[4]; const bf16_t* gb[2 * NI];
#pragma unroll
  for (int i = 0; i < 4; ++i) { int q = i * NTHR + tid, R = q >> 3, pc = q & 7, c = pc ^ ((R >> 1) & 7); ga[i] = A + (long)R * lda + c * 8; }
#pragma unroll
  for (int i = 0; i < 2 * NI; ++i) { int q = i * NTHR + tid, R = q >> 3, pc = q & 7, c = pc ^ ((R >> 1) & 7); int Rg = (R & ~31) + vperm(R & 31); gb[i] = B + (long)Rg * ldb + c * 8; }
  const int sw = (r32 >> 1) & 7;
  int xo[4];
#pragma unroll
  for (int ks = 0; ks < 4; ++ks) xo[ks] = r32 * 128 + (((2 * ks + hi) ^ sw) << 4);
  const int a_base = (128 * wr) * 128, b_base = A_BYTES + (32 * NI * wc) * 128;
#define GL_A(sb_, i, kt) __builtin_amdgcn_global_load_lds((const unsigned*)(ga[i] + (kt) * 64), (unsigned*)((sb_) + ((i) * NTHR + wbase_) * 16), 16, 0, 0)
#define GL_B(sb_, i, kt) __builtin_amdgcn_global_load_lds((const unsigned*)(gb[i] + (kt) * 64), (unsigned*)((sb_) + A_BYTES + ((i) * NTHR + wbase_) * 16), 16, 0, 0)
  {
#pragma unroll
    for (int i = 0; i < 4; ++i) GL_A(lds, i, 0);
#pragma unroll
    for (int i = 0; i < 2 * NI; ++i) GL_B(lds, i, 0);
  }
#pragma unroll 1
  for (int kt = 0; kt < KT; ++kt) {
    asm volatile("s_waitcnt vmcnt(0)" ::: "memory");
    __syncthreads();
    const bool more = kt + 1 < KT;
    char* sn = lds + ((kt + 1) & 1) * STAGE;
    const char* sb = lds + (kt & 1) * STAGE;
    bf16x8 af[2][4], bfr[2][NI];
#define FRAG_RD(S, ks) do { _Pragma("unroll") for (int ni = 0; ni < NI; ++ni) bfr[S][ni] = *(const bf16x8*)(sb + b_base + ni * 4096 + xo[ks]);   \
                            _Pragma("unroll") for (int mi = 0; mi < 4; ++mi) af[S][mi] = *(const bf16x8*)(sb + a_base + mi * 4096 + xo[ks]); } while (0)
    FRAG_RD(0, 0);
#pragma unroll
    for (int ks = 0; ks < 4; ++ks) {
      const int cs = ks & 1;
      if (ks < 3) { if (cs == 0) FRAG_RD(1, ks + 1); else FRAG_RD(0, ks + 1); }
      SBAR();
#pragma unroll
      for (int mi = 0; mi < 2; ++mi)
#pragma unroll
        for (int ni = 0; ni < NI; ++ni) acc[mi][ni] = __builtin_amdgcn_mfma_f32_32x32x16_bf16(bfr[cs][ni], af[cs][mi], acc[mi][ni], 0, 0, 0);
      SBAR();
      if (more) { GL_A(sn, ks, kt + 1); if (NI == 2) { GL_B(sn, ks, kt + 1); } else if (ks < 2) { GL_B(sn, ks, kt + 1); } }
      SBAR();
#pragma unroll
      for (int mi = 2; mi < 4; ++mi)
#pragma unroll
        for (int ni = 0; ni < NI; ++ni) acc[mi][ni] = __builtin_amdgcn_mfma_f32_32x32x16_bf16(bfr[cs][ni], af[cs][mi], acc[mi][ni], 0, 0, 0);
    }
#undef FRAG_RD
  }
#undef GL_A
#undef GL_B
}

#define ST8(ptr, V, O) do { u32x4 w_ = {cvtpk(V[(O) + 0], V[(O) + 1]), cvtpk(V[(O) + 2], V[(O) + 3]), cvtpk(V[(O) + 4], V[(O) + 5]), cvtpk(V[(O) + 6], V[(O) + 7])}; *(u32x4*)(ptr) = w_; } while (0)

struct G1Ptrs { bf16_t *U, *CGb, *Qb, *Kb, *Vb, *AGb, *MCb, *MAb; const f32x2* rope; const float* biasv; int seqmask; };
template <int KIND>
__device__ __forceinline__ void g1_block(const f32x16& a, const G1Ptrs& P, int row, int vc0, int hi) {
  float v[16];
#pragma unroll
  for (int j = 0; j < 4; ++j) { f32x4 b4 = *(const f32x4*)(P.biasv + vc0 + 4 * j); v[4 * j] = a[4 * j] + b4[0]; v[4 * j + 1] = a[4 * j + 1] + b4[1]; v[4 * j + 2] = a[4 * j + 2] + b4[2]; v[4 * j + 3] = a[4 * j + 3] + b4[3]; }
  if constexpr (KIND == 0) {
    float o[8];
#pragma unroll
    for (int j = 0; j < 8; ++j) o[j] = v[j] * sigmoidf_(v[8 + j]);
    ST8(P.U + (long)row * 512 + (vc0 >> 1), o, 0);
  } else if constexpr (KIND == 1 || KIND == 5) {
    float o[16];
#pragma unroll
    for (int j = 0; j < 16; ++j) o[j] = siluf_(v[j]);
    bf16_t* d = (KIND == 1) ? (P.CGb + (long)row * 512 + (vc0 - 1024)) : (P.AGb + (long)row * 512 + (vc0 - 3072)); ST8(d, o, 0); ST8(d + 8, o, 8);
  } else if constexpr (KIND == 2 || KIND == 3) {
    constexpr bool isq = (KIND == 2); const int j0 = vc0 - (isq ? 1536 : 2048);
    const int b = j0 >> 5, gq = b >> 1, sub = b & 1, d0 = 16 * sub + 8 * hi;
    const int pos = row & P.seqmask;
    const f32x2* cs = P.rope + (long)pos * 32 + d0;
    float o1[8], o2[8]; constexpr float sc = isq ? QSCALE : 1.f;
#pragma unroll
    for (int j = 0; j < 4; ++j) { f32x4 c2 = *(const f32x4*)(cs + 2 * j);
      o1[2 * j] = (v[2 * j] * c2[0] - v[8 + 2 * j] * c2[1]) * sc; o2[2 * j] = (v[8 + 2 * j] * c2[0] + v[2 * j] * c2[1]) * sc;
      o1[2 * j + 1] = (v[2 * j + 1] * c2[2] - v[9 + 2 * j] * c2[3]) * sc; o2[2 * j + 1] = (v[9 + 2 * j] * c2[2] + v[2 * j + 1] * c2[3]) * sc; }
    bf16_t* d = (isq ? P.Qb : P.Kb) + (long)row * 512 + 64 * gq + d0; ST8(d, o1, 0); ST8(d + 32, o2, 0);
  } else if constexpr (KIND == 4) {
    bf16_t* d = P.Vb + (long)row * 512 + (vc0 - 2560); ST8(d, v, 0); ST8(d + 8, v, 8);
  } else {
    float o[16];
#pragma unroll
    for (int j = 0; j < 16; ++j) o[j] = sigmoidf_(v[j]);
    bf16_t* d = (KIND == 6) ? (P.MCb + (long)row * 1024 + (vc0 - 3584)) : (P.MAb + (long)row * 1024 + (vc0 - 4608)); ST8(d, o, 0); ST8(d + 8, o, 8);
  }
}
template <int KIND>
__device__ __forceinline__ void g1_epi(const f32x16 (&acc)[4][2], const G1Ptrs& P, int row0, int vcb, int hi) {
#define G1B(mi, ni) g1_block<KIND>(acc[mi][ni], P, row0 + 32 * (mi), vcb + 32 * (ni), hi); SBAR();
  G1B(0, 0) G1B(1, 0) G1B(2, 0) G1B(3, 0) G1B(0, 1) G1B(1, 1) G1B(2, 1) G1B(3, 1)
#undef G1B
}
__device__ __forceinline__ void phase_gemm1(const Params& p, int g, char* lds, int vid) {
  unsigned char* ws = p.ws;
  const bf16_t* Xb = (g == 0) ? (const bf16_t*)(ws + OFF_XB) : (const bf16_t*)((unsigned char*)p.out + (size_t)TG * DM * 4);
  const bf16_t* W = (const bf16_t*)(ws + OFF_WIN);
  G1Ptrs P;
  P.biasv = (const float*)(ws + OFF_BIASV); P.rope = (const f32x2*)(ws + OFF_ROPE);
  P.U = (bf16_t*)(ws + OFF_U); P.CGb = (bf16_t*)(ws + OFF_CG); P.Qb = (bf16_t*)(ws + OFF_Q); P.Kb = (bf16_t*)(ws + OFF_K);
  P.Vb = (bf16_t*)(ws + OFF_V); P.AGb = (bf16_t*)(ws + OFF_AG); P.MCb = (bf16_t*)(ws + OFF_MC); P.MAb = (bf16_t*)(ws + OFF_MA);
  P.seqmask = (g == 0) ? 16383 : 8191;
  const int tid = otid(), wid = tid >> 6, lane = tid & 63, wr = wid >> 2, wc = wid & 3, r32 = lane & 31, hi = lane >> 5;
  const int xg = vid & 7, jl = vid >> 3;
  for (int rnd = 0; rnd < 5; ++rnd) {
    int pm = 8 * xg + (jl & 7); const int pn = rnd * 4 + (jl >> 3);
    asm volatile("" : "+s"(pm));
    f32x16 acc[4][2];
#pragma unroll
    for (int mi = 0; mi < 4; ++mi)
#pragma unroll
      for (int ni = 0; ni < 2; ++ni) acc[mi][ni] = f32x16{};
    gemm_loop<2>(Xb + (long)pm * 256 * DM, DM, W + (long)pn * 256 * DM, DM, DM / 64, lds, acc);
    const int row0 = pm * 256 + 128 * wr + r32, vcb = pn * 256 + 64 * wc + 16 * hi;
    if (pn < 4) g1_epi<0>(acc, P, row0, vcb, hi);
    else if (pn < 6) g1_epi<1>(acc, P, row0, vcb, hi);
    else if (pn < 8) g1_epi<2>(acc, P, row0, vcb, hi);
    else if (pn < 10) g1_epi<3>(acc, P, row0, vcb, hi);
    else if (pn < 12) g1_epi<4>(acc, P, row0, vcb, hi);
    else if (pn < 14) g1_epi<5>(acc, P, row0, vcb, hi);
    else if (pn < 18) g1_epi<6>(acc, P, row0, vcb, hi);
    else g1_epi<7>(acc, P, row0, vcb, hi);
  }
  {
    int pm = 8 * xg + (jl & 7); const int n0 = 20 * 256 + 128 * (jl >> 3);
    asm volatile("" : "+s"(pm));
    f32x16 acc1[4][1];
#pragma unroll
    for (int mi = 0; mi < 4; ++mi) acc1[mi][0] = f32x16{};
    gemm_loop<1>(Xb + (long)pm * 256 * DM, DM, W + (long)n0 * DM, DM, DM / 64, lds, acc1);
    const int row0 = pm * 256 + 128 * wr + r32, vc0 = n0 + 32 * wc + 16 * hi;
    g1_block<7>(acc1[0][0], P, row0, vc0, hi); SBAR();
    g1_block<7>(acc1[1][0], P, row0 + 32, vc0, hi); SBAR();
    g1_block<7>(acc1[2][0], P, row0 + 64, vc0, hi); SBAR();
    g1_block<7>(acc1[3][0], P, row0 + 96, vc0, hi); SBAR();
  }
}

__device__ __forceinline__ void phase_conv(const Params& p, int g, char* lds) {
  unsigned char* ws = p.ws;
  const bf16_t* U = (const bf16_t*)(ws + OFF_U); const bf16_t* CGb = (const bf16_t*)(ws + OFF_CG); bf16_t* U2 = (bf16_t*)(ws + OFF_U2);
  const int tid = otid(), wid = tid >> 6, lane = tid & 63;
  const int seqlen = (g == 0) ? 16384 : 8192;
  unsigned* IN = (unsigned*)lds;
  float* OUT = (float*)(lds + 65536);
  const int cp = tid & 255, half = tid >> 8;
  float w0[31], w1[31];
#pragma unroll
  for (int j = 0; j < 31; ++j) { f32x2 w = *(const f32x2*)(p.conv_dw + j * 512 + 2 * cp); w0[j] = w[0]; w1[j] = w[1]; }
  const f32x2 cb = *(const f32x2*)(p.conv_dw_b + 2 * cp);
  for (int t = blockIdx.x; t < TG / 32; t += gridDim.x) {
    const int t0 = t * 32, slo = t0 & ~(seqlen - 1), shi = slo + seqlen;
    __syncthreads();
    for (int q = tid; q < 62 * 64; q += NTHR) { int r = q >> 6, c = q & 63; int tok = t0 - 15 + r; u32x4 v = {0u, 0u, 0u, 0u};
      if (tok >= slo && tok < shi) v = *(const u32x4*)(U + (long)tok * 512 + c * 8);
      *(u32x4*)(IN + r * 256 + c * 4) = v; }
    __syncthreads();
    float a0[16], a1[16];
#pragma unroll
    for (int i = 0; i < 16; ++i) { a0[i] = cb[0]; a1[i] = cb[1]; }
#pragma unroll
    for (int ti = 0; ti < 46; ++ti) {
      const unsigned w = IN[(16 * half + ti) * 256 + cp]; const float x0 = bflo(w), x1 = bfhi(w);
#pragma unroll
      for (int to = 0; to < 16; ++to) { const int j = ti - to; if (j >= 0 && j <= 30) { a0[to] = fmaf(w0[j], x0, a0[to]); a1[to] = fmaf(w1[j], x1, a1[to]); } }
    }
#pragma unroll
    for (int to = 0; to < 16; ++to) *(f32x2*)(OUT + (16 * half + to) * 512 + 2 * cp) = f32x2{a0[to], a1[to]};
    __syncthreads();
#pragma unroll
    for (int i = 0; i < 4; ++i) {
      const int tl = wid * 4 + i; const float* src = OUT + tl * 512 + lane * 8;
      f32x4 xa = *(const f32x4*)src, xb = *(const f32x4*)(src + 4);
      float x[8] = {xa[0], xa[1], xa[2], xa[3], xb[0], xb[1], xb[2], xb[3]};
      float s = 0.f;
#pragma unroll
      for (int j = 0; j < 8; ++j) s += x[j];
#pragma unroll
      for (int m = 1; m < 64; m <<= 1) s += __shfl_xor(s, m);
      const float mean = s * (1.f / 512.f); float q = 0.f;
#pragma unroll
      for (int j = 0; j < 8; ++j) { x[j] -= mean; q += x[j] * x[j]; }
#pragma unroll
      for (int m = 1; m < 64; m <<= 1) q += __shfl_xor(q, m);
      const float rstd = rsqrtf(q * (1.f / 512.f) + LN_EPS);
      const long tok = t0 + tl;
      f32x4 g0 = *(const f32x4*)(p.conv_ln_g + lane * 8), g1 = *(const f32x4*)(p.conv_ln_g + lane * 8 + 4);
      f32x4 b0 = *(const f32x4*)(p.conv_ln_b + lane * 8), b1 = *(const f32x4*)(p.conv_ln_b + lane * 8 + 4);
      const float gg[8] = {g0[0], g0[1], g0[2], g0[3], g1[0], g1[1], g1[2], g1[3]}, bb[8] = {b0[0], b0[1], b0[2], b0[3], b1[0], b1[1], b1[2], b1[3]};
      u32x4 cgw = *(const u32x4*)(CGb + tok * 512 + lane * 8);
      const float cgv[8] = {bflo(cgw[0]), bfhi(cgw[0]), bflo(cgw[1]), bfhi(cgw[1]), bflo(cgw[2]), bfhi(cgw[2]), bflo(cgw[3]), bfhi(cgw[3])};
      float o[8];
#pragma unroll
      for (int j = 0; j < 8; ++j) o[j] = siluf_(x[j] * rstd * gg[j] + bb[j]) * cgv[j];
      ST8(U2 + tok * 512 + lane * 8, o, 0);
    }
  }
}

#define KSWZ(row, colB) ((row) * 256 + ((colB) ^ (((row) & 7) << 4)))
constexpr float ATHR = 11.5f;
constexpr int SHM_V = 64 * 128 * 2, SHM_K = 64 * 128 * 2;
__device__ __forceinline__ float vmax3(float a, float b, float c) { float r; asm("v_max3_f32 %0, %1, %2, %3" : "=v"(r) : "v"(a), "v"(b), "v"(c)); return r; }
__device__ __forceinline__ float sm_max_a(const f32x16& p0) {
  float pm = vmax3(p0[0], p0[1], p0[2]);
#pragma unroll
  for (int r = 3; r < 15; r += 2) pm = vmax3(pm, p0[r], p0[r + 1]);
  return pm;
}
template <bool FIRST>
__device__ __forceinline__ void sm_max_b(float pm, f32x16& p0, f32x16& p1, float& m_reg, float& alpha, f32x16& cinit) {
  float pmax = vmax3(pm, p0[15], p1[0]);
#pragma unroll
  for (int r = 1; r < 15; r += 2) pmax = vmax3(pmax, p1[r], p1[r + 1]);
  pmax = fmaxf(pmax, p1[15]);
  { auto rr = __builtin_amdgcn_permlane32_swap(__float_as_uint(pmax), __float_as_uint(pmax), false, false);
    pmax = fmaxf(__uint_as_float(rr[0]), __uint_as_float(rr[1])); }
  alpha = 1.f;
  if (FIRST || !__builtin_expect(__all(pmax <= ATHR), 1)) {
    const float delta = FIRST ? pmax : fmaxf(pmax, 0.f);
    alpha = __builtin_amdgcn_exp2f(-delta); m_reg += delta;
#pragma unroll
    for (int r = 0; r < 16; ++r) { p0[r] -= delta; p1[r] -= delta; cinit[r] = -m_reg; }
  }
}
__device__ __forceinline__ void sm_exp(f32x16& p) {
#pragma unroll
  for (int r = 0; r < 16; ++r) p[r] = __builtin_amdgcn_exp2f(p[r]);
}
__device__ __forceinline__ void finishSM(f32x16& p0, f32x16& p1, float alpha, float& l_reg, bf16x8& pa0, bf16x8& pa1, bf16x8& pa2, bf16x8& pa3) {
  float ps = 0, ps2 = 0;
#pragma unroll
  for (int r = 0; r < 16; ++r) { ps += p0[r]; ps2 += p1[r]; }
  ps += ps2;
  { auto rr = __builtin_amdgcn_permlane32_swap(__float_as_uint(ps), __float_as_uint(ps), false, false);
    ps = __uint_as_float(rr[0]) + __uint_as_float(rr[1]); }
  l_reg = l_reg * alpha + ps;
#define PK4(P, BASE, OUT) do { u32x4 w = {cvtpk(P[BASE + 0], P[BASE + 1]), cvtpk(P[BASE + 2], P[BASE + 3]), cvtpk(P[BASE + 4], P[BASE + 5]), cvtpk(P[BASE + 6], P[BASE + 7])}; \
    OUT = *reinterpret_cast<bf16x8*>(&w); } while (0)
  PK4(p0, 0, pa0); PK4(p0, 8, pa1); PK4(p1, 0, pa2); PK4(p1, 8, pa3);
#undef PK4
}
__device__ __forceinline__ void qkt(f32x16& p0, f32x16& p1, const char* Ks, const bf16x8* qr, int r32, int hi, int comp, const f32x16& cinit) {
#pragma unroll
  for (int d0 = 0; d0 < 4; ++d0) { int cb = (comp * 64 + d0 * 16 + hi * 8) * 2;
    bf16x8 b0 = *reinterpret_cast<const bf16x8*>(Ks + KSWZ(r32, cb));
    bf16x8 b1 = *reinterpret_cast<const bf16x8*>(Ks + KSWZ(32 + r32, cb));
    if (d0 == 0) { p0 = __builtin_amdgcn_mfma_f32_32x32x16_bf16(b0, qr[d0], cinit, 0, 0, 0); p1 = __builtin_amdgcn_mfma_f32_32x32x16_bf16(b1, qr[d0], cinit, 0, 0, 0); }
    else { p0 = __builtin_amdgcn_mfma_f32_32x32x16_bf16(b0, qr[d0], p0, 0, 0, 0); p1 = __builtin_amdgcn_mfma_f32_32x32x16_bf16(b1, qr[d0], p1, 0, 0, 0); } }
}
__device__ __forceinline__ int v_st(int k, int c) { const int kk = (k & ~0xC) | ((k & 4) << 1) | ((k & 8) >> 1); return ((kk >> 3) * 4 + (c >> 5)) * 512 + ((kk & 7) * 32 + (c & 31)) * 2; }
__device__ __forceinline__ int v_rd_base(int lane) { return ((lane & 3) << 3) | (((lane >> 2) & 3) << 6) | (((lane >> 4) & 1) << 5) | (((lane >> 5) & 1) << 8); }
constexpr int v_rd_off(int d0, int ks, int half) { return d0 * 512 + ks * 4096 + half * 2048; }
template <int OFF> __device__ __forceinline__ s16x4 tr_read(int vb) {
  s16x4 r; asm volatile("ds_read_b64_tr_b16 %0, %1 offset:%2" : "=&v"(r) : "v"(vb), "i"(OFF) : "memory"); return r;
}
template <int D0> __device__ __forceinline__ void pv_one(f32x16& od, int vb, bf16x8 pa0, bf16x8 pa1, bf16x8 pa2, bf16x8 pa3) {
  const s16x4 l0 = tr_read<v_rd_off(D0, 0, 0)>(vb), h0 = tr_read<v_rd_off(D0, 0, 1)>(vb), l1 = tr_read<v_rd_off(D0, 1, 0)>(vb), h1 = tr_read<v_rd_off(D0, 1, 1)>(vb);
  const s16x4 l2 = tr_read<v_rd_off(D0, 2, 0)>(vb), h2 = tr_read<v_rd_off(D0, 2, 1)>(vb), l3 = tr_read<v_rd_off(D0, 3, 0)>(vb), h3 = tr_read<v_rd_off(D0, 3, 1)>(vb);
  asm volatile("s_waitcnt lgkmcnt(0)" ::: "memory"); SBAR();
#define PK(L, H) (bf16x8){L[0], L[1], L[2], L[3], H[0], H[1], H[2], H[3]}
  od = __builtin_amdgcn_mfma_f32_32x32x16_bf16(pa0, PK(l0, h0), od, 0, 0, 0);
  od = __builtin_amdgcn_mfma_f32_32x32x16_bf16(pa1, PK(l1, h1), od, 0, 0, 0);
  od = __builtin_amdgcn_mfma_f32_32x32x16_bf16(pa2, PK(l2, h2), od, 0, 0, 0);
  od = __builtin_amdgcn_mfma_f32_32x32x16_bf16(pa3, PK(l3, h3), od, 0, 0, 0);
#undef PK
}

typedef float f32x2_t_ __attribute__((ext_vector_type(2))); typedef __bf16 bf16x2_t_ __attribute__((ext_vector_type(2)));
__device__ __forceinline__ unsigned cvtpk_s(float lo, float hi) { f32x2_t_ v = {lo, hi}; bf16x2_t_ b = __builtin_convertvector(v, bf16x2_t_); return __builtin_bit_cast(unsigned, b); }
typedef __attribute__((address_space(3))) const char* lds_cptr;
typedef short v4i16_t_ __attribute__((ext_vector_type(4)));
__device__ __forceinline__ s16x4 vtr(lds_cptr p) { return __builtin_bit_cast(s16x4, __builtin_amdgcn_ds_read_tr16_b64_v4i16((__attribute__((address_space(3))) v4i16_t_*)p)); }
__device__ __forceinline__ void attn_unit(const bf16_t* __restrict__ Qb, const bf16_t* __restrict__ Kh, const bf16_t* __restrict__ Vh, const bf16_t* __restrict__ AGb,
                                          bf16_t* __restrict__ O2b, int seq, float lam, const float* __restrict__ subg, char* lds) {
  constexpr int LDK = 512;
  const int tid = otid(), wid = tid >> 6, lane = tid & 63, r32 = lane & 31, hi = lane >> 5, rowgrp = wid & 3, comp = wid >> 2;
  constexpr int BUFB = SHM_V + SHM_K;
  float* wsl = (float*)(lds + 3 * BUFB) + wid * 64; float* li_l = wsl; float* al_l = wsl + 32;
  float m_reg = 0.f, l_reg = 0; f32x16 o[4] = {}; bf16x8 qr[4]; f32x16 cinit = {};
  const int vb0 = (int)(uintptr_t)lds + v_rd_base(lane);
  const int wid_s = __builtin_amdgcn_readfirstlane(wid);
  const bf16_t* ksrc[2]; const bf16_t* vsrc[2];
#pragma unroll
  for (int i = 0; i < 2; ++i) {
    const int pk = 2 * wid + i, row = 4 * pk + (lane >> 4), chunk = (lane & 15) ^ (row & 7);
    ksrc[i] = Kh + (long)row * LDK + chunk * 8;
    const int q = 64 * pk + lane, sti = q >> 5, kkl = (q >> 2) & 7, cq = q & 3, kk = (sti >> 2) * 8 + kkl, c = (sti & 3) * 32 + cq * 8, k = kk;
    vsrc[i] = Vh + (long)k * LDK + c;
  }
#define DMA_TILE(t, ob) do { char* d_ = lds + (ob) + wid_s * 2048; const long to_ = (long)(t) * 64 * LDK;                                  \
    __builtin_amdgcn_global_load_lds((const unsigned*)(vsrc[0] + to_), (unsigned*)(d_), 16, 0, 0);                                              \
    __builtin_amdgcn_global_load_lds((const unsigned*)(vsrc[1] + to_), (unsigned*)(d_ + 1024), 16, 0, 0);                                       \
    __builtin_amdgcn_global_load_lds((const unsigned*)(ksrc[0] + to_), (unsigned*)(d_ + SHM_V), 16, 0, 0);                                      \
    __builtin_amdgcn_global_load_lds((const unsigned*)(ksrc[1] + to_), (unsigned*)(d_ + SHM_V + 1024), 16, 0, 0); } while (0)
#define TILE_BAR() do { asm volatile("s_waitcnt vmcnt(0) lgkmcnt(0)" ::: "memory"); __builtin_amdgcn_s_barrier(); asm volatile("" ::: "memory"); } while (0)
#define RESC(a) do { if (__any((a) < 1.f)) { if (hi == 0) al_l[r32] = (a); asm volatile("s_waitcnt lgkmcnt(0)" ::: "memory"); \
    _Pragma("unroll") for (int d = 0; d < 4; ++d) _Pragma("unroll") for (int r = 0; r < 16; ++r) o[d][r] *= al_l[crow(r, hi)]; } } while (0)
  DMA_TILE(0, 0); DMA_TILE(1, BUFB);
  const bf16_t* Qw = Qb + (long)(rowgrp * 32 + r32) * LDK + comp * 64 + hi * 8;
#pragma unroll
  for (int d0 = 0; d0 < 4; ++d0) qr[d0] = *(const bf16x8*)(Qw + d0 * 16);
  f32x16 pA0, pA1, pB0, pB1; float alA, alB; bf16x8 pa0, pa1, pa2, pa3; const int NT = seq / 64;
  float pmx;
#define PV_SM(VB, P0, P1, AL) do {                                                                    \
    pv_one<0>(o[0], VB, pa0, pa1, pa2, pa3); pmx = sm_max_a(P0);                                       \
    pv_one<1>(o[1], VB, pa0, pa1, pa2, pa3); sm_max_b<false>(pmx, P0, P1, m_reg, AL, cinit);           \
    pv_one<2>(o[2], VB, pa0, pa1, pa2, pa3); sm_exp(P0);                                               \
    pv_one<3>(o[3], VB, pa0, pa1, pa2, pa3); sm_exp(P1); } while (0)
  TILE_BAR();
  qkt(pA0, pA1, lds + SHM_V, qr, r32, hi, comp, cinit); pmx = sm_max_a(pA0); sm_max_b<true>(pmx, pA0, pA1, m_reg, alA, cinit); alA = 1.f; sm_exp(pA0); sm_exp(pA1);
  int obp = 0, obc = BUFB, obn = 2 * BUFB;
  const int kx0 = r32 * 256 + ((comp * 128 + 0 * 32 + hi * 16) ^ ((r32 & 7) << 4)), kx1 = r32 * 256 + ((comp * 128 + 1 * 32 + hi * 16) ^ ((r32 & 7) << 4));
  const int kx2 = r32 * 256 + ((comp * 128 + 2 * 32 + hi * 16) ^ ((r32 & 7) << 4)), kx3 = r32 * 256 + ((comp * 128 + 3 * 32 + hi * 16) ^ ((r32 & 7) << 4));
  const int vrb = v_rd_base(lane);
#define PIN(x) asm volatile("" : "+v"(x))
#define MX3(a, b, c) __builtin_fmaxf(__builtin_fmaxf((a), (b)), (c))
#define KF(off) (*reinterpret_cast<const bf16x8*>(kb_ + (off)))
#define KP(p) (*reinterpret_cast<const bf16x8*>(p))
#define MF(a, b, c) __builtin_amdgcn_mfma_f32_32x32x16_bf16(a, b, c, 0, 0, 0)
#define VRD(i) do { vlo[i] = vtr(vp_ + v_rd_off((i) & 3, (i) >> 2, 0)); vhi[i] = vtr(vp_ + v_rd_off((i) & 3, (i) >> 2, 1)); } while (0)
#define VFR(i) (bf16x8){vlo[i][0], vlo[i][1], vlo[i][2], vlo[i][3], vhi[i][0], vhi[i][1], vhi[i][2], vhi[i][3]}
#define SWP(OUT) do { u32x4 w_ = {ca0, ca1, cb0, cb1}; OUT = *reinterpret_cast<bf16x8*>(&w_); } while (0)
#define GQA(MFS, P, B) do { MFS; sacc += P[B]; sacc += P[B + 1]; sacc += P[B + 2]; sacc += P[B + 3]; PIN(sacc); ca0 = cvtpk_s(P[B], P[B + 1]); ca1 = cvtpk_s(P[B + 2], P[B + 3]); PIN(ca0); PIN(ca1); SBAR(); } while (0)
#define GQB(MFS, P, B, OUT) do { MFS; sacc += P[B]; sacc += P[B + 1]; sacc += P[B + 2]; sacc += P[B + 3]; PIN(sacc); cb0 = cvtpk_s(P[B], P[B + 1]); cb1 = cvtpk_s(P[B + 2], P[B + 3]); SWP(OUT); PIN(OUT); SBAR(); } while (0)
#define GPM(i, PAk, X0, X1, X2, X3) do { if ((i) + 2 < 16) VRD((i) + 2); o[(i) & 3] = MF(PAk, VFR(i), o[(i) & 3]); rm_ = MX3(rm_, X0, X1); rm_ = MX3(rm_, X2, X3); PIN(rm_); SBAR(); } while (0)
#define GPE(i, PAk, X, B) do { if ((i) + 2 < 16) VRD((i) + 2); o[(i) & 3] = MF(PAk, VFR(i), o[(i) & 3]); X[B] = __builtin_amdgcn_exp2f(X[B]); X[B + 1] = __builtin_amdgcn_exp2f(X[B + 1]); \
    X[B + 2] = __builtin_amdgcn_exp2f(X[B + 2]); X[B + 3] = __builtin_amdgcn_exp2f(X[B + 3]); PIN(X); SBAR(); } while (0)
#define GPX(i, PAk, X, B) do { if ((i) + 2 < 16) VRD((i) + 2); o[(i) & 3] = MF(PAk, VFR(i), o[(i) & 3]); X[B] = __builtin_amdgcn_exp2f(X[B]); X[B + 1] = __builtin_amdgcn_exp2f(X[B + 1]); PIN(X); SBAR(); } while (0)
#define STEP(C0, C1, P0, P1, AL) do { SBAR();                                                                                    \
    const char* kb_ = lds + obc + SHM_V; const lds_cptr vp_ = (lds_cptr)lds + obp + vrb;                                            \
    s16x4 vlo[16], vhi[16]; unsigned ca0, ca1, cb0, cb1; float sacc = 0.f;                                                        \
    const char* k0_ = kb_ + kx0; const char* k1_ = kb_ + kx1; const char* k2_ = kb_ + kx2; const char* k3_ = kb_ + kx3;                 \
    const bf16x8 kf0 = KP(k0_), kf1 = KP(k0_ + 8192), kf2 = KP(k1_), kf3 = KP(k1_ + 8192); SBAR();                                \
    GQA(C0 = MF(kf0, qr[0], cinit), P0, 0);                                                                                       \
    const bf16x8 kf4 = KP(k2_), kf5 = KP(k2_ + 8192), kf6 = KP(k3_), kf7 = KP(k3_ + 8192);                                        \
    GQB(C1 = MF(kf1, qr[0], cinit), P0, 4, pa0);                                                                                  \
    GQA(C0 = MF(kf2, qr[1], C0), P0, 8);  GQB(C1 = MF(kf3, qr[1], C1), P0, 12, pa1);                                              \
    VRD(0);                                                                                                                       \
    GQA(C0 = MF(kf4, qr[2], C0), P1, 0);  GQB(C1 = MF(kf5, qr[2], C1), P1, 4, pa2);                                               \
    VRD(1);                                                                                                                       \
    GQA(C0 = MF(kf6, qr[3], C0), P1, 8);  GQB(C1 = MF(kf7, qr[3], C1), P1, 12, pa3);                                              \
    float ps_; { auto rr_ = __builtin_amdgcn_permlane32_swap(__float_as_uint(sacc), __float_as_uint(sacc), false, false);        \
      ps_ = __uint_as_float(rr_[0]) + __uint_as_float(rr_[1]); }                                                                  \
    l_reg += ps_; AL = 1.f;                                                                                                       \
    if (!__builtin_expect(__all(ps_ <= PTHR), 1)) { const float dl_ = fmaxf(__log2f(ps_), 0.f); AL = __builtin_amdgcn_exp2f(-dl_); m_reg += dl_;   \
      _Pragma("unroll") for (int r = 0; r < 16; ++r) { C0[r] -= dl_; C1[r] -= dl_; cinit[r] = -m_reg; } }                            \
    SBAR();                                                                                                                       \
    GPX(0, pa0, C0, 0);  GPX(1, pa0, C0, 2);  GPX(2, pa0, C0, 4);   GPX(3, pa0, C0, 6);                                           \
    GPX(4, pa1, C0, 8);  GPX(5, pa1, C0, 10); GPX(6, pa1, C0, 12);  GPX(7, pa1, C0, 14);                                          \
    GPX(8, pa2, C1, 0);  GPX(9, pa2, C1, 2);  GPX(10, pa2, C1, 4);  GPX(11, pa2, C1, 6);                                          \
    GPX(12, pa3, C1, 8); GPX(13, pa3, C1, 10); GPX(14, pa3, C1, 12); GPX(15, pa3, C1, 14);                                        \
    if (__any(AL < 1.f)) { if (hi == 0) al_l[r32] = AL; asm volatile("s_waitcnt lgkmcnt(0)" ::: "memory"); l_reg *= AL;          \
      _Pragma("unroll") for (int d = 0; d < 4; ++d) _Pragma("unroll") for (int r = 0; r < 16; ++r) o[d][r] *= al_l[crow(r, hi)]; } \
  } while (0)
  constexpr float PTHR = 2896.3f;
  { float alS;
  for (int j = 1; j + 1 < NT; j += 2) {
    DMA_TILE(j + 1, obn);
    STEP(pB0, pB1, pA0, pA1, alS);
    TILE_BAR();
    { const int t_ = obp; obp = obc; obc = obn; obn = t_; }
    if (j + 2 < NT) DMA_TILE(j + 2, obn);
    STEP(pA0, pA1, pB0, pB1, alS);
    TILE_BAR();
    { const int t_ = obp; obp = obc; obc = obn; obn = t_; }
  } }
  alA = 1.f;
#undef GPX
#undef STEP
#undef GPE
#undef GPM
#undef GQB
#undef GQA
#undef SWP
#undef VFR
#undef VRD
#undef MF
#undef KF
#undef KP
#undef PIN
#undef MX3
  SBAR(); qkt(pB0, pB1, lds + obc + SHM_V, qr, r32, hi, comp, cinit);
  finishSM(pA0, pA1, alA, l_reg, pa0, pa1, pa2, pa3); SBAR();
  PV_SM(vb0 + obp, pB0, pB1, alB);
  RESC(alB);
  finishSM(pB0, pB1, alB, l_reg, pa0, pa1, pa2, pa3); SBAR();
  pv_one<0>(o[0], vb0 + obc, pa0, pa1, pa2, pa3); pv_one<1>(o[1], vb0 + obc, pa0, pa1, pa2, pa3);
  pv_one<2>(o[2], vb0 + obc, pa0, pa1, pa2, pa3); pv_one<3>(o[3], vb0 + obc, pa0, pa1, pa2, pa3);
#undef PV_SM
#undef DMA_TILE
#undef TILE_BAR
#undef RESC
  asm volatile("s_waitcnt vmcnt(0)" ::: "memory");
  __syncthreads();
  float* X = (float*)lds;
  if (hi == 0) li_l[r32] = l_reg;
  asm volatile("s_waitcnt lgkmcnt(0)" ::: "memory");
  float rli[16];
#pragma unroll
  for (int r = 0; r < 16; ++r) rli[r] = __builtin_amdgcn_rcpf(li_l[crow(r, hi)]);
  if (comp == 0) {
#pragma unroll
    for (int r = 0; r < 16; ++r)
#pragma unroll
      for (int d0 = 0; d0 < 4; ++d0) X[(rowgrp * 32 + crow(r, hi)) * 128 + d0 * 32 + r32] = o[d0][r] * rli[r];
  }
  __syncthreads();
  if (comp == 1) {
#pragma unroll
    for (int r = 0; r < 16; ++r)
#pragma unroll
      for (int d0 = 0; d0 < 4; ++d0) { float* xp = X + (rowgrp * 32 + crow(r, hi)) * 128 + d0 * 32 + r32; *xp = *xp - lam * (o[d0][r] * rli[r]); }
  }
  __syncthreads();
  {
    const int row = tid >> 2, c0 = (tid & 3) * 32;
    float v[32]; float ss = 0.f;
#pragma unroll
    for (int i = 0; i < 8; ++i) { f32x4 x4 = *(const f32x4*)(X + row * 128 + c0 + 4 * i); v[4 * i] = x4[0]; v[4 * i + 1] = x4[1]; v[4 * i + 2] = x4[2]; v[4 * i + 3] = x4[3]; }
#pragma unroll
    for (int i = 0; i < 32; ++i) ss += v[i] * v[i];
    ss += __shfl_xor(ss, 1); ss += __shfl_xor(ss, 2);
    const float rs = rsqrtf(ss * (1.f / 128.f) + LN_EPS) * (1.f - LAM_INIT);
#pragma unroll
    for (int i = 0; i < 4; ++i) {
      u32x4 gw = *(const u32x4*)(AGb + (long)row * 512 + c0 + 8 * i);
      f32x4 s0 = *(const f32x4*)(subg + c0 + 8 * i), s1 = *(const f32x4*)(subg + c0 + 8 * i + 4);
      float ov[8];
      ov[0] = v[8 * i + 0] * rs * s0[0] * bflo(gw[0]); ov[1] = v[8 * i + 1] * rs * s0[1] * bfhi(gw[0]);
      ov[2] = v[8 * i + 2] * rs * s0[2] * bflo(gw[1]); ov[3] = v[8 * i + 3] * rs * s0[3] * bfhi(gw[1]);
      ov[4] = v[8 * i + 4] * rs * s1[0] * bflo(gw[2]); ov[5] = v[8 * i + 5] * rs * s1[1] * bfhi(gw[2]);
      ov[6] = v[8 * i + 6] * rs * s1[2] * bflo(gw[3]); ov[7] = v[8 * i + 7] * rs * s1[3] * bfhi(gw[3]);
      ST8(O2b + (long)row * 512 + c0 + 8 * i, ov, 0);
    }
  }
  __syncthreads();
}

__device__ __forceinline__ void phase_attn(const Params& p, int g, char* lds, int vid) {
  unsigned char* ws = p.ws;
  const bf16_t* Qb = (const bf16_t*)(ws + OFF_Q); const bf16_t* Kb = (const bf16_t*)(ws + OFF_K); const bf16_t* Vb = (const bf16_t*)(ws + OFF_V);
  const bf16_t* AGb = (const bf16_t*)(ws + OFF_AG); bf16_t* O2 = (bf16_t*)(ws + OFF_O2);
  const float lam = *(const float*)(ws + OFF_MISC);
  const int x = vid & 7, jj = vid >> 3, nper = 32;
  for (int u = jj; u < 64; u += nper) {
    int head, seq0, seq, qb;
    if (g == 0) { head = x >> 1; seq0 = 0; seq = 16384; qb = (x & 1) * 64 + u; }
    else { head = x & 3; seq0 = (x >> 2) * 8192; seq = 8192; qb = u; }
    const long qrow = seq0 + (long)qb * 128;
    attn_unit(Qb + qrow * 512 + head * 128, Kb + (long)seq0 * 512 + head * 128, Vb + (long)seq0 * 512 + head * 128, AGb + qrow * 512 + head * 128,
              O2 + qrow * 512 + head * 128, seq, lam, p.subln_g, lds);
  }
}

__device__ __forceinline__ void g2_block(const f32x16& a1, const f32x16& a2, const bf16_t* MCb, const bf16_t* MAb, bf16_t* MG, const float* bcp, long row, int c0) {
  u32x4 mc0 = *(const u32x4*)(MCb + row * 1024 + c0), mc1 = *(const u32x4*)(MCb + row * 1024 + c0 + 8);
  u32x4 ma0 = *(const u32x4*)(MAb + row * 1024 + c0), ma1 = *(const u32x4*)(MAb + row * 1024 + c0 + 8);
  float bc[16];
#pragma unroll
  for (int j = 0; j < 4; ++j) { f32x4 b4 = *(const f32x4*)(bcp + c0 + 4 * j); bc[4 * j] = b4[0]; bc[4 * j + 1] = b4[1]; bc[4 * j + 2] = b4[2]; bc[4 * j + 3] = b4[3]; }
  float o[16];
#pragma unroll
  for (int j = 0; j < 4; ++j) {
    o[2 * j] = bflo(mc0[j]) * (a1[2 * j] + bc[2 * j]) + bflo(ma0[j]) * a2[2 * j];
    o[2 * j + 1] = bfhi(mc0[j]) * (a1[2 * j + 1] + bc[2 * j + 1]) + bfhi(ma0[j]) * a2[2 * j + 1];
    o[8 + 2 * j] = bflo(mc1[j]) * (a1[8 + 2 * j] + bc[8 + 2 * j]) + bflo(ma1[j]) * a2[8 + 2 * j];
    o[8 + 2 * j + 1] = bfhi(mc1[j]) * (a1[8 + 2 * j + 1] + bc[8 + 2 * j + 1]) + bfhi(ma1[j]) * a2[8 + 2 * j + 1];
  }
  ST8(MG + row * 1024 + c0, o, 0); ST8(MG + row * 1024 + c0 + 8, o, 8);
}
__device__ __forceinline__ void phase_gemm2(const Params& p, char* lds, int vid) {
  unsigned char* ws = p.ws;
  const bf16_t* U2 = (const bf16_t*)(ws + OFF_U2); const bf16_t* O2 = (const bf16_t*)(ws + OFF_O2);
  const bf16_t* Wcp = (const bf16_t*)(ws + OFF_WCP); const bf16_t* Wao = (const bf16_t*)(ws + OFF_WAO);
  const bf16_t* MCb = (const bf16_t*)(ws + OFF_MC); const bf16_t* MAb = (const bf16_t*)(ws + OFF_MA); bf16_t* MG = (bf16_t*)(ws + OFF_XB);
  const int tid = otid(), wid = tid >> 6, lane = tid & 63, wr = wid >> 2, wc = wid & 3, r32 = lane & 31, hi = lane >> 5;
  const int xg = vid & 7, jl = vid >> 3;
  for (int rnd = 0; rnd < 2; ++rnd) {
    int pm = 8 * xg + (jl & 7); const int pn = rnd * 4 + (jl >> 3);
    asm volatile("" : "+s"(pm));
    f32x16 a1[4][1], a2[4][1];
#pragma unroll
    for (int mi = 0; mi < 4; ++mi) { a1[mi][0] = f32x16{}; a2[mi][0] = f32x16{}; }
    gemm_loop<1>(U2 + (long)pm * 256 * 512, 512, Wcp + (long)pn * 128 * 512, 512, 8, lds, a1);
    gemm_loop<1>(O2 + (long)pm * 256 * 512, 512, Wao + (long)pn * 128 * 512, 512, 8, lds, a2);
    const int c0 = pn * 128 + 32 * wc + 16 * hi;
    const long row0 = pm * 256 + 128 * wr + r32;
    g2_block(a1[0][0], a2[0][0], MCb, MAb, MG, p.b_cp, row0, c0); SBAR();
    g2_block(a1[1][0], a2[1][0], MCb, MAb, MG, p.b_cp, row0 + 32, c0); SBAR();
    g2_block(a1[2][0], a2[2][0], MCb, MAb, MG, p.b_cp, row0 + 64, c0); SBAR();
    g2_block(a1[3][0], a2[3][0], MCb, MAb, MG, p.b_cp, row0 + 96, c0); SBAR();
  }
}

__device__ __forceinline__ void phase_gemm3(const Params& p, int g, char* lds, int vid) {
  unsigned char* ws = p.ws;
  const bf16_t* MG = (const bf16_t*)(ws + OFF_XB); const bf16_t* Wo = (const bf16_t*)(ws + OFF_WOUT);
  const float* x = p.x[g]; float* out = p.out + (size_t)g * TG * DM;
  const int tid = otid(), wid = tid >> 6, lane = tid & 63, wr = wid >> 2, wc = wid & 3, r32 = lane & 31, hi = lane >> 5;
  const int xg = vid & 7, jl = vid >> 3;
  {
    const int pm = 8 * xg + (jl & 7), pn = (jl >> 3);
    f32x16 acc[4][2];
#pragma unroll
    for (int mi = 0; mi < 4; ++mi)
#pragma unroll
      for (int ni = 0; ni < 2; ++ni) acc[mi][ni] = f32x16{};
    gemm_loop<2>(MG + (long)pm * 256 * DM, DM, Wo + (long)pn * 256 * DM, DM, DM / 64, lds, acc);
#pragma unroll
    for (int ni = 0; ni < 2; ++ni) {
      const int c0 = pn * 256 + 64 * wc + 32 * ni + 16 * hi;
      f32x4 bo[4];
#pragma unroll
      for (int j = 0; j < 4; ++j) bo[j] = *(const f32x4*)(p.b_out + c0 + 4 * j);
#pragma unroll
      for (int mi = 0; mi < 4; ++mi) {
        const long row = pm * 256 + 128 * wr + 32 * mi + r32;
#pragma unroll
        for (int j = 0; j < 4; ++j) {
          f32x4 xv = *(const f32x4*)(x + row * DM + c0 + 4 * j); f32x4 r;
          r[0] = acc[mi][ni][4 * j] + bo[j][0] + ALPHA * xv[0]; r[1] = acc[mi][ni][4 * j + 1] + bo[j][1] + ALPHA * xv[1];
          r[2] = acc[mi][ni][4 * j + 2] + bo[j][2] + ALPHA * xv[2]; r[3] = acc[mi][ni][4 * j + 3] + bo[j][3] + ALPHA * xv[3];
          *(f32x4*)(out + row * DM + c0 + 4 * j) = r;
        }
      }
    }
  }
}

namespace pg8 {
#define PG8_LAS __attribute__((address_space(3)))
constexpr int BM = 256, BK = 64, HALF = 128, HTB = HALF * BK * 2, STAGE_BYTES = 8 * HTB;
__device__ __forceinline__ int lds_byte(int r, int c) { const int st = (r >> 4) * 2 + (c >> 5), rr = r & 15, cc = c & 31, ob = rr * 64 + cc * 2; return st * 1024 + (ob ^ (((ob >> 9) & 1) << 5)); }
__device__ __forceinline__ void stage_rc(int b, int& R, int& C) { const int st = b / 1024, sb = b % 1024, swz = sb ^ (((sb >> 9) & 1) << 5); R = (st >> 1) * 16 + swz / 64; C = (st & 1) * 32 + (swz % 64) / 2; }
__device__ __forceinline__ int perm32(int rho) { const int n = rho >> 4, i = rho & 15; return 8 * (i >> 2) + 4 * n + (i & 3); }
struct Unit { int pm, pn; };
struct Gemm { const bf16_t* A; const bf16_t* Bt; int M, N, K; };
struct GroupOrder {
  int xg, jl, npn;
  __device__ __forceinline__ bool next(int i, Unit& u) const { int pm_ = 8 * xg + (jl & 7); asm volatile("" : "+s"(pm_));
    u.pm = pm_; u.pn = 4 * i + (jl >> 3); return u.pn < npn; }
  __device__ __forceinline__ void a_ready(const Unit&) const {}
  __device__ __forceinline__ void done(const Unit&) const {}
};
template <class Epi, class Sched, bool ALIGN_EPI = false, bool SP2 = false>
__device__ __forceinline__ void gemm_phase(PG8_LAS unsigned char* lds, const Gemm g, const Sched& S, const Epi& E) {
    const int tid = otid(), wid = __builtin_amdgcn_readfirstlane(tid >> 6), lane = tid & 63, wr = wid >> 2, wc = wid & 3, fr = lane & 15, fq = lane >> 4;
    const int K = g.K, nt = K / BK;
    unsigned voffA[2], voffB[2];
#pragma unroll
    for (int i = 0; i < 2; ++i) { int R, C; stage_rc(tid * 16 + i * 8192, R, C); const int Rb = Epi::PERM ? ((R & ~31) + perm32(R & 31)) : R;
        voffA[i] = (unsigned)(R * K + C) * 2u; voffB[i] = (unsigned)(Rb * K + C) * 2u; }
    const size_t kstep = (size_t)(BK * 2);
    const size_t hstep = (size_t)HALF * K * 2;
    const size_t tstep = 2 * hstep;
    const unsigned ldsw = (unsigned)wid * 1024u;
    const int aoff = lds_byte(wr * 64 + fr, fq * 8), boff = lds_byte(wc * 32 + fr, fq * 8);
#define PG8_SA(b, h) (((b) * 2 + (h)) * HTB)
#define PG8_SB(b, h) ((4 + (b) * 2 + (h)) * HTB)
#define PG8_STAGE(bufoff, gbase, voff) do { _Pragma("unroll") for (int _i = 0; _i < 2; ++_i) \
        __builtin_amdgcn_global_load_lds((const unsigned*)((const char*)(gbase) + (voff)[_i]), (PG8_LAS unsigned*)(lds + (bufoff) + ldsw + _i * 8192), 16, 0, 0); } while (0)
#define PG8_LDA(dst, b, h) do { _Pragma("unroll") for (int m = 0; m < 4; ++m) _Pragma("unroll") for (int k = 0; k < 2; ++k) dst[m][k] = *(const PG8_LAS bf16x8*)(lds + PG8_SA(b, h) + aoff + m * 2048 + k * 1024); } while (0)
#define PG8_LDB(dst, b, h) do { _Pragma("unroll") for (int n = 0; n < 2; ++n) _Pragma("unroll") for (int k = 0; k < 2; ++k) dst[n][k] = *(const PG8_LAS bf16x8*)(lds + PG8_SB(b, h) + boff + n * 2048 + k * 1024); } while (0)
#define PG8_MMA(ai, bj, At, Bt) do { __builtin_amdgcn_s_setprio(1); _Pragma("unroll") for (int m = 0; m < 4; ++m) _Pragma("unroll") for (int n = 0; n < 2; ++n) _Pragma("unroll") for (int k = 0; k < 2; ++k) \
        acc[ai][bj][m][n] = __builtin_amdgcn_mfma_f32_16x16x32_bf16(Bt[n][k], At[m][k], acc[ai][bj][m][n], 0, 0, 0); __builtin_amdgcn_s_setprio(0); } while (0)
#define PG8_WAIT_V(n) asm volatile("s_waitcnt vmcnt(" #n ")" ::: "memory")
#define PG8_WAIT_L(n) asm volatile("s_waitcnt lgkmcnt(" #n ")" ::: "memory")
#define PG8_BAR __builtin_amdgcn_s_barrier()
#define PG8_SCHED __builtin_amdgcn_sched_barrier(0)
    Unit cur, nxt; int ui = 0;
    if (!S.next(0, cur)) return;
    f32x4 acc[2][2][4][2];
#pragma unroll
    for (int a = 0; a < 2; ++a)
#pragma unroll
        for (int b = 0; b < 2; ++b)
#pragma unroll
            for (int m = 0; m < 4; ++m)
#pragma unroll
                for (int n = 0; n < 2; ++n) acc[a][b][m][n] = (f32x4){0.f, 0.f, 0.f, 0.f};
    bf16x8 At[4][2], B0[2][2], B1[2][2];
    const char* cA = (const char*)g.A + (size_t)cur.pm * tstep; const char* cB = (const char*)g.Bt + (size_t)cur.pn * tstep;
    S.a_ready(cur);
    if constexpr (SP2) {
        PG8_STAGE(PG8_SB(0, 0), cB, voffB); PG8_STAGE(PG8_SB(0, 1), cB + hstep, voffB); PG8_STAGE(PG8_SA(0, 0), cA, voffA); PG8_STAGE(PG8_SA(0, 1), cA + hstep, voffA);
        if (wr == 1) PG8_BAR;
        PG8_WAIT_V(2); PG8_BAR;
        PG8_STAGE(PG8_SB(1, 0), cB + kstep, voffB); PG8_STAGE(PG8_SA(1, 0), cA + kstep, voffA); PG8_STAGE(PG8_SB(1, 1), cB + hstep + kstep, voffB);
        PG8_WAIT_V(6); PG8_BAR;
    } else {
        PG8_STAGE(PG8_SB(0, 0), cB, voffB); PG8_STAGE(PG8_SA(0, 0), cA, voffA); PG8_STAGE(PG8_SB(0, 1), cB + hstep, voffB); PG8_STAGE(PG8_SA(0, 1), cA + hstep, voffA);
        if (wr == 1) PG8_BAR;
        PG8_WAIT_V(4); PG8_BAR;
        PG8_STAGE(PG8_SB(1, 0), cB + kstep, voffB); PG8_STAGE(PG8_SA(1, 0), cA + kstep, voffA); PG8_STAGE(PG8_SB(1, 1), cB + hstep + kstep, voffB);
        PG8_WAIT_V(6); PG8_BAR;
    }
    for (;;) {
        const bool has_next = S.next(ui + 1, nxt);
        const char* nA = has_next ? (const char*)g.A + (size_t)nxt.pm * tstep : cA; const char* nB = has_next ? (const char*)g.Bt + (size_t)nxt.pn * tstep : cB;
        for (int t = 0; t < nt; t += 2) {
            const bool last = (t == nt - 2);
            const char* a1 = cA + (size_t)(t + 1) * kstep;
            const char* a2 = last ? nA : cA + (size_t)(t + 2) * kstep; const char* b2 = last ? nB : cB + (size_t)(t + 2) * kstep;
            const char* a3 = a2 + kstep; const char* b3 = b2 + kstep;
            if (last && has_next) S.a_ready(nxt);
            if constexpr (SP2) {
            PG8_LDB(B0, 0, 0); PG8_LDB(B1, 0, 1); PG8_SCHED; PG8_LDA(At, 0, 0); PG8_STAGE(PG8_SA(1, 1), a1 + hstep, voffA);
            PG8_WAIT_V(8); PG8_WAIT_L(0); PG8_BAR; PG8_MMA(0, 0, At, B0); PG8_MMA(0, 1, At, B1); PG8_BAR; PG8_SCHED;
            PG8_LDA(At, 0, 1); PG8_STAGE(PG8_SB(0, 0), b2, voffB); PG8_STAGE(PG8_SB(0, 1), b2 + hstep, voffB); PG8_STAGE(PG8_SA(0, 0), a2, voffA);
            PG8_WAIT_V(8); PG8_WAIT_L(0); PG8_BAR; PG8_MMA(1, 0, At, B0); PG8_MMA(1, 1, At, B1); PG8_BAR; PG8_SCHED;
            PG8_LDB(B0, 1, 0); PG8_LDB(B1, 1, 1); PG8_SCHED; PG8_LDA(At, 1, 0); PG8_STAGE(PG8_SA(0, 1), a2 + hstep, voffA);
            PG8_WAIT_V(8); PG8_WAIT_L(0); PG8_BAR; PG8_MMA(0, 0, At, B0); PG8_MMA(0, 1, At, B1); PG8_BAR; PG8_SCHED;
            PG8_LDA(At, 1, 1); PG8_STAGE(PG8_SB(1, 0), b3, voffB); PG8_STAGE(PG8_SB(1, 1), b3 + hstep, voffB); PG8_STAGE(PG8_SA(1, 0), a3, voffA);
            PG8_WAIT_V(8); PG8_WAIT_L(0); PG8_BAR; PG8_MMA(1, 0, At, B0); PG8_MMA(1, 1, At, B1); PG8_BAR; PG8_SCHED;
            } else {
            PG8_LDB(B0, 0, 0); PG8_SCHED; PG8_LDA(At, 0, 0); PG8_STAGE(PG8_SA(1, 1), a1 + hstep, voffA);
            PG8_WAIT_L(8); PG8_BAR; PG8_WAIT_L(0); PG8_MMA(0, 0, At, B0); PG8_BAR; PG8_SCHED;
            PG8_LDB(B1, 0, 1); PG8_STAGE(PG8_SB(0, 0), b2, voffB);
            PG8_BAR; PG8_WAIT_L(0); PG8_MMA(0, 1, At, B1); PG8_BAR;
            PG8_LDA(At, 0, 1); PG8_STAGE(PG8_SA(0, 0), a2, voffA);
            PG8_BAR; PG8_WAIT_L(0); PG8_MMA(1, 0, At, B0); PG8_BAR; PG8_SCHED;
            PG8_STAGE(PG8_SB(0, 1), b2 + hstep, voffB);
            PG8_WAIT_V(6); PG8_BAR; PG8_MMA(1, 1, At, B1); PG8_BAR;
            PG8_LDB(B0, 1, 0); PG8_SCHED; PG8_LDA(At, 1, 0); PG8_STAGE(PG8_SA(0, 1), a2 + hstep, voffA);
            PG8_WAIT_L(8); PG8_BAR; PG8_WAIT_L(0); PG8_MMA(0, 0, At, B0); PG8_BAR; PG8_SCHED;
            PG8_LDB(B1, 1, 1); PG8_STAGE(PG8_SB(1, 0), b3, voffB);
            PG8_BAR; PG8_WAIT_L(0); PG8_MMA(0, 1, At, B1); PG8_BAR;
            PG8_LDA(At, 1, 1); PG8_STAGE(PG8_SA(1, 0), a3, voffA);
            PG8_BAR; PG8_WAIT_L(0); PG8_MMA(1, 0, At, B0); PG8_BAR; PG8_SCHED;
            PG8_STAGE(PG8_SB(1, 1), b3 + hstep, voffB);
            PG8_WAIT_V(6); PG8_BAR; PG8_MMA(1, 1, At, B1); PG8_BAR;
            }
        }
        if constexpr (ALIGN_EPI) { if (wr == 0) PG8_BAR; }
        if constexpr (!Epi::AFTER_DRAIN) { E(acc, cur, wr, wc, fr, fq); S.done(cur); }
        if (!has_next) break;
#pragma unroll
        for (int a = 0; a < 2; ++a)
#pragma unroll
            for (int b = 0; b < 2; ++b)
#pragma unroll
                for (int m = 0; m < 4; ++m)
#pragma unroll
                    for (int n = 0; n < 2; ++n) acc[a][b][m][n] = (f32x4){0.f, 0.f, 0.f, 0.f};
        cur = nxt; cA = nA; cB = nB; ++ui;
        if constexpr (ALIGN_EPI) { if (wr == 1) PG8_BAR; }
    }
    PG8_WAIT_V(0);
    if constexpr (!ALIGN_EPI) { if (wr == 0) PG8_BAR; }
    PG8_BAR;
    if constexpr (Epi::AFTER_DRAIN) { E.fused(acc, cur, wr, wc, fr, fq, lds, wid, lane); S.done(cur); }
#undef PG8_SA
#undef PG8_SB
#undef PG8_STAGE
#undef PG8_LDA
#undef PG8_LDB
#undef PG8_MMA
#undef PG8_WAIT_V
#undef PG8_WAIT_L
#undef PG8_BAR
#undef PG8_SCHED
}
}

#define ST4(ptr, V, O) do { u32x2 w_ = {cvtpk(V[(O) + 0], V[(O) + 1]), cvtpk(V[(O) + 2], V[(O) + 3])}; *(u32x2*)(ptr) = w_; } while (0)
#define PG8_FOREACH(acc, u, F) do {                                                                                   \
    _Pragma("unroll") for (int ai = 0; ai < 2; ++ai) _Pragma("unroll") for (int bj = 0; bj < 2; ++bj) _Pragma("unroll") for (int m = 0; m < 4; ++m) {   \
      const int row_ = (u).pm * 256 + ai * 128 + wr * 64 + m * 16 + fr, c0_ = (u).pn * 256 + bj * 128 + wc * 32 + 8 * fq;   \
      F(acc[ai][bj][m][0], acc[ai][bj][m][1], row_, c0_); SBAR(); } } while (0)

struct EpiG3 {
  static constexpr bool PERM = true, AFTER_DRAIN = false;
  const float* x; float* out; const float* bo;
  __device__ __forceinline__ void blk(const f32x4& a0, const f32x4& a1, int row, int c0) const {
    const f32x4 b0 = *(const f32x4*)(bo + c0), b1 = *(const f32x4*)(bo + c0 + 4);
    const f32x4 x0 = *(const f32x4*)(x + (long)row * DM + c0), x1 = *(const f32x4*)(x + (long)row * DM + c0 + 4);
    *(f32x4*)(out + (long)row * DM + c0) = a0 + b0 + ALPHA * x0;
    *(f32x4*)(out + (long)row * DM + c0 + 4) = a1 + b1 + ALPHA * x1;
  }
  __device__ __forceinline__ void operator()(const f32x4 (&acc)[2][2][4][2], const pg8::Unit& u, int wr, int wc, int fr, int fq) const {
#define G3F(A0, A1, R, C) blk(A0, A1, R, C)
    PG8_FOREACH(acc, u, G3F);
#undef G3F
  }
};
__device__ __forceinline__ void phase_gemm3_new(const Params& p, int g, char* lds, int vid) {
  unsigned char* ws = p.ws;
  EpiG3 E; E.x = p.x[g]; E.out = p.out + (size_t)g * TG * DM; E.bo = p.b_out;
  pg8::Gemm G; G.A = (const bf16_t*)(ws + OFF_XB); G.Bt = (const bf16_t*)(ws + OFF_WOUT); G.M = TG; G.N = 1024; G.K = DM;
  pg8::GroupOrder S; S.xg = vid & 7; S.jl = vid >> 3; S.npn = 4;
  pg8::gemm_phase<EpiG3, pg8::GroupOrder, false, true>((PG8_LAS unsigned char*)lds, G, S, E);
}

struct EpiG1n {
  static constexpr bool PERM = true, AFTER_DRAIN = false;
  bf16_t *U, *CGb, *Qb, *Kb, *Vb, *AGb, *MCb, *MAb; const f32x2* rope; const float* biasv; int seqmask;
  template <int KIND> __device__ __forceinline__ void blk(const f32x4& a0, const f32x4& a1, int row, int c0) const {
    const f32x4 b0 = *(const f32x4*)(biasv + c0), b1 = *(const f32x4*)(biasv + c0 + 4);
    float v[8] = {a0[0] + b0[0], a0[1] + b0[1], a0[2] + b0[2], a0[3] + b0[3], a1[0] + b1[0], a1[1] + b1[1], a1[2] + b1[2], a1[3] + b1[3]};
    if constexpr (KIND == 0 || KIND == 2 || KIND == 3) {
      float w[8];
#pragma unroll
      for (int j = 0; j < 8; ++j) w[j] = __shfl_xor(v[j], 16);
      const int par = (c0 >> 3) & 1, cg = c0 & ~15;
      if constexpr (KIND == 0) {
        if (par == 0) { float o[8];
#pragma unroll
          for (int j = 0; j < 8; ++j) o[j] = v[j] * sigmoidf_(w[j]);
          ST8(U + (long)row * 512 + (cg >> 1), o, 0); }
      } else {
        constexpr bool isq = (KIND == 2); const int j0 = cg - (isq ? 1536 : 2048), b = j0 >> 5, gq = b >> 1, sub = b & 1, d0 = 16 * sub + 8 * ((j0 >> 4) & 1);
        const int pos = row & seqmask;
        const f32x2* cs = rope + (long)pos * 32 + d0;
        const f32x4 c01 = *(const f32x4*)cs, c23 = *(const f32x4*)(cs + 2), c45 = *(const f32x4*)(cs + 4), c67 = *(const f32x4*)(cs + 6);
        const float cc[8] = {c01[0], c01[2], c23[0], c23[2], c45[0], c45[2], c67[0], c67[2]}, sn[8] = {c01[1], c01[3], c23[1], c23[3], c45[1], c45[3], c67[1], c67[3]};
        float o[8]; constexpr float sc = isq ? QSCALE : 1.f; const float sg = par ? 1.f : -1.f;
#pragma unroll
        for (int j = 0; j < 8; ++j) o[j] = (v[j] * cc[j] + sg * (w[j] * sn[j])) * sc;
        ST8((isq ? Qb : Kb) + (long)row * 512 + 64 * gq + d0 + 32 * par, o, 0);
      }
    } else if constexpr (KIND == 1 || KIND == 5) {
      float o[8];
#pragma unroll
      for (int j = 0; j < 8; ++j) o[j] = siluf_(v[j]);
      bf16_t* dp = (KIND == 1) ? (CGb + (long)row * 512 + (c0 - 1024)) : (AGb + (long)row * 512 + (c0 - 3072)); ST8(dp, o, 0);
    } else if constexpr (KIND == 4) {
      ST8(Vb + (long)row * 512 + (c0 - 2560), v, 0);
    } else {
      float o[8];
#pragma unroll
      for (int j = 0; j < 8; ++j) o[j] = sigmoidf_(v[j]);
      bf16_t* dp = (KIND == 6) ? (MCb + (long)row * 1024 + (c0 - 3584)) : (MAb + (long)row * 1024 + (c0 - 4608)); ST8(dp, o, 0);
    }
  }
  template <int KIND> __device__ __forceinline__ void all(const f32x4 (&acc)[2][2][4][2], const pg8::Unit& u, int wr, int wc, int fr, int fq) const {
#define G1F(A0, A1, R, C) blk<KIND>(A0, A1, R, C)
    PG8_FOREACH(acc, u, G1F);
#undef G1F
  }
  __device__ __forceinline__ void operator()(const f32x4 (&acc)[2][2][4][2], const pg8::Unit& u, int wr, int wc, int fr, int fq) const {
    const int pn = u.pn;
    if (pn < 4) all<0>(acc, u, wr, wc, fr, fq);
    else if (pn < 6) all<1>(acc, u, wr, wc, fr, fq);
    else if (pn < 8) all<2>(acc, u, wr, wc, fr, fq);
    else if (pn < 10) all<3>(acc, u, wr, wc, fr, fq);
    else if (pn < 12) all<4>(acc, u, wr, wc, fr, fq);
    else if (pn < 14) all<5>(acc, u, wr, wc, fr, fq);
    else if (pn < 18) all<6>(acc, u, wr, wc, fr, fq);
    else all<7>(acc, u, wr, wc, fr, fq);
  }
};
__device__ __forceinline__ void phase_gemm1_new(const Params& p, int g, char* lds, int vid) {
  unsigned char* ws = p.ws;
  EpiG1n E;
  E.biasv = (const float*)(ws + OFF_BIASV); E.rope = (const f32x2*)(ws + OFF_ROPE);
  E.U = (bf16_t*)(ws + OFF_U); E.CGb = (bf16_t*)(ws + OFF_CG); E.Qb = (bf16_t*)(ws + OFF_Q); E.Kb = (bf16_t*)(ws + OFF_K);
  E.Vb = (bf16_t*)(ws + OFF_V); E.AGb = (bf16_t*)(ws + OFF_AG); E.MCb = (bf16_t*)(ws + OFF_MC); E.MAb = (bf16_t*)(ws + OFF_MA);
  E.seqmask = (g == 0) ? 16383 : 8191;
  pg8::Gemm G; G.A = (g == 0) ? (const bf16_t*)(ws + OFF_XB) : (const bf16_t*)((unsigned char*)p.out + (size_t)TG * DM * 4); G.Bt = (const bf16_t*)(ws + OFF_WIN); G.M = TG; G.N = NV; G.K = DM;
  pg8::GroupOrder S; S.xg = vid & 7; S.jl = vid >> 3; S.npn = 20;
  pg8::gemm_phase<EpiG1n, pg8::GroupOrder, true, true>((PG8_LAS unsigned char*)lds, G, S, E);
  {
    const int tid = otid(), wid = tid >> 6, lane = tid & 63, wr = wid >> 2, wc = wid & 3, r32 = lane & 31, hi = lane >> 5;
    const int xg = vid & 7, jl = vid >> 3;
    G1Ptrs P; P.biasv = E.biasv; P.rope = E.rope; P.U = E.U; P.CGb = E.CGb; P.Qb = E.Qb; P.Kb = E.Kb; P.Vb = E.Vb; P.AGb = E.AGb; P.MCb = E.MCb; P.MAb = E.MAb; P.seqmask = E.seqmask;
    int pm = 8 * xg + (jl & 7); const int n0 = 20 * 256 + 128 * (jl >> 3);
    asm volatile("" : "+s"(pm));
    f32x16 acc1[4][1];
#pragma unroll
    for (int mi = 0; mi < 4; ++mi) acc1[mi][0] = f32x16{};
    gemm_loop<1>(G.A + (long)pm * 256 * DM, DM, G.Bt + (long)n0 * DM, DM, DM / 64, lds, acc1);
    const int row0 = pm * 256 + 128 * wr + r32, vc0 = n0 + 32 * wc + 16 * hi;
    g1_block<7>(acc1[0][0], P, row0, vc0, hi); SBAR();
    g1_block<7>(acc1[1][0], P, row0 + 32, vc0, hi); SBAR();
    g1_block<7>(acc1[2][0], P, row0 + 64, vc0, hi); SBAR();
    g1_block<7>(acc1[3][0], P, row0 + 96, vc0, hi); SBAR();
  }
}

__device__ __forceinline__ void phase_ln(const Params& p, int g) {
  float* out = p.out + (size_t)g * TG * DM;
  const int tid = otid(), wid = tid >> 6, lane = tid & 63;
  for (int row = blockIdx.x * 8 + wid; row < TG; row += gridDim.x * 8) {
    float* rp = out + (long)row * DM;
    f32x4 v[4]; float s = 0.f;
#pragma unroll
    for (int i = 0; i < 4; ++i) { v[i] = *(const f32x4*)(rp + i * 256 + lane * 4); s += (v[i][0] + v[i][1]) + (v[i][2] + v[i][3]); }
#pragma unroll
    for (int m = 1; m < 64; m <<= 1) s += __shfl_xor(s, m);
    const float mean = s * (1.f / 1024.f); float q = 0.f;
#pragma unroll
    for (int i = 0; i < 4; ++i) { v[i] = v[i] - mean; q += (v[i][0] * v[i][0] + v[i][1] * v[i][1]) + (v[i][2] * v[i][2] + v[i][3] * v[i][3]); }
#pragma unroll
    for (int m = 1; m < 64; m <<= 1) q += __shfl_xor(q, m);
    const float rstd = rsqrtf(q * (1.f / 1024.f) + LN_EPS);
#pragma unroll
    for (int i = 0; i < 4; ++i) { f32x4 gg = *(const f32x4*)(p.ln_g + i * 256 + lane * 4), bb = *(const f32x4*)(p.ln_b + i * 256 + lane * 4);
      *(f32x4*)(rp + i * 256 + lane * 4) = v[i] * rstd * gg + bb; }
  }
}

__device__ __forceinline__ void phase_prologue(const Params& p, char* lds) {
  unsigned char* ws = p.ws;
  int bi = 0;
  for (int t = blockIdx.x; t < 1920; t += gridDim.x, ++bi) {
    if (t < 1408) transpose_tile(p, bi, p.w_in, NV, 1024, (bf16_t*)(ws + OFF_WIN), true, t >> 4, t & 15, lds);
    else if (t < 1536) transpose_tile(p, bi, p.w_cp, 1024, 512, (bf16_t*)(ws + OFF_WCP), false, (t - 1408) >> 3, (t - 1408) & 7, lds);
    else if (t < 1664) transpose_tile(p, bi, p.w_ao, 1024, 512, (bf16_t*)(ws + OFF_WAO), false, (t - 1536) >> 3, (t - 1536) & 7, lds);
    else transpose_tile(p, bi, p.w_out, 1024, 1024, (bf16_t*)(ws + OFF_WOUT), false, (t - 1664) >> 4, (t - 1664) & 15, lds);
  }
  for (; bi < 8; ++bi) cvt_batch(p, bi);
  const long gt = (long)blockIdx.x * NTHR + threadIdx.x, gn = (long)gridDim.x * NTHR;
  float* biasv = (float*)(ws + OFF_BIASV);
  for (long i = gt; i < NV; i += gn) biasv[i] = p.b_in[win_actual((int)i)];
  f32x2* rope = (f32x2*)(ws + OFF_ROPE);
  for (long i = gt; i < 16384L * 32; i += gn) { const int pos = (int)(i >> 5), f = (int)(i & 31); const double a = (double)pos * p.inv_freq_pi[f];
    rope[i] = f32x2{(float)cospi(a), (float)sinpi(a)}; }
  if (gt == 0) { float s1 = 0.f, s2 = 0.f; for (int i = 0; i < 64; ++i) { s1 += p.lq1[i] * p.lk1[i]; s2 += p.lq2[i] * p.lk2[i]; }
    *(float*)(ws + OFF_MISC) = expf(s1) - expf(s2) + LAM_INIT; }
}

__device__ __forceinline__ void panel_arrive(unsigned* cnt) {
  asm volatile("s_waitcnt vmcnt(0) lgkmcnt(0)" ::: "memory"); __syncthreads();
  if (threadIdx.x == 0) { __builtin_amdgcn_fence(__ATOMIC_RELEASE, "agent"); asm volatile("s_waitcnt vmcnt(0)" ::: "memory");
    __hip_atomic_fetch_add(cnt, 1u, __ATOMIC_RELAXED, __HIP_MEMORY_SCOPE_AGENT); }
}
__device__ __forceinline__ void panel_wait(unsigned* cnt, unsigned want) {
  if (threadIdx.x == 0) { while (__hip_atomic_load(cnt, __ATOMIC_RELAXED, __HIP_MEMORY_SCOPE_AGENT) < want) __builtin_amdgcn_s_sleep(1);
    __builtin_amdgcn_fence(__ATOMIC_ACQUIRE, "agent"); asm volatile("s_waitcnt vmcnt(0)" ::: "memory"); }
  __syncthreads();
}
__device__ __forceinline__ void phase_ln_panel(const Params& p, int g, int vid) {
  float* out = p.out + (size_t)g * TG * DM;
  const int tid = otid(), wid = tid >> 6, lane = tid & 63;
  const int xg = vid & 7, jl = vid >> 3, row0 = (8 * xg + (jl & 7)) * 256 + (jl >> 3) * 64 + wid * 8;
  f32x4 gg[4], bb[4];
#pragma unroll
  for (int k = 0; k < 4; ++k) { gg[k] = *(const f32x4*)(p.ln_g + k * 256 + lane * 4); bb[k] = *(const f32x4*)(p.ln_b + k * 256 + lane * 4); }
#pragma unroll 1
  for (int ib = 0; ib < 8; ib += 4) {
    f32x4 v[4][4];
#pragma unroll
    for (int i = 0; i < 4; ++i)
#pragma unroll
      for (int k = 0; k < 4; ++k) v[i][k] = *(const f32x4*)(out + (long)(row0 + ib + i) * DM + k * 256 + lane * 4);
#pragma unroll
    for (int i = 0; i < 4; ++i) {
      float* rp = out + (long)(row0 + ib + i) * DM;
      float sm = 0.f;
#pragma unroll
      for (int k = 0; k < 4; ++k) sm += (v[i][k][0] + v[i][k][1]) + (v[i][k][2] + v[i][k][3]);
#pragma unroll
      for (int m = 1; m < 64; m <<= 1) sm += __shfl_xor(sm, m);
      const float mean = sm * (1.f / 1024.f); float q = 0.f;
#pragma unroll
      for (int k = 0; k < 4; ++k) { v[i][k] = v[i][k] - mean; q += (v[i][k][0] * v[i][k][0] + v[i][k][1] * v[i][k][1]) + (v[i][k][2] * v[i][k][2] + v[i][k][3] * v[i][k][3]); }
#pragma unroll
      for (int m = 1; m < 64; m <<= 1) q += __shfl_xor(q, m);
      const float rstd = rsqrtf(q * (1.f / 1024.f) + LN_EPS);
#pragma unroll
      for (int k = 0; k < 4; ++k) *(f32x4*)(rp + k * 256 + lane * 4) = v[i][k] * rstd * gg[k] + bb[k];
    }
  }
}

__global__ void __launch_bounds__(NTHR, 2) fwd_kernel(Params p) {
  extern __shared__ __attribute__((aligned(16))) char lds[];
#if MULTI_LAUNCH
#define GSYNC() do { } while (0)
#else
  cg::grid_group grid = cg::this_grid();
  unsigned* bar = (unsigned*)(p.ws + OFF_BAR); unsigned bar_target = 0; bool first_sync = false;
#define GSYNC() do { if (first_sync) { first_sync = false; grid.sync(); } else {                                             \
    asm volatile("s_waitcnt vmcnt(0) lgkmcnt(0)" ::: "memory"); __syncthreads(); bar_target += gridDim.x;                  \
    if (threadIdx.x == 0) { __builtin_amdgcn_fence(__ATOMIC_RELEASE, "agent"); asm volatile("s_waitcnt vmcnt(0)" ::: "memory");   \
      __hip_atomic_fetch_add(bar, 1u, __ATOMIC_RELAXED, __HIP_MEMORY_SCOPE_AGENT);                                         \
      while (__hip_atomic_load(bar, __ATOMIC_RELAXED, __HIP_MEMORY_SCOPE_AGENT) < bar_target) __builtin_amdgcn_s_sleep(2); \
      __builtin_amdgcn_fence(__ATOMIC_ACQUIRE, "agent"); asm volatile("s_waitcnt vmcnt(0)" ::: "memory"); }               \
    __syncthreads(); } } while (0)
#endif
  int vid = blockIdx.x;
#if !MULTI_LAUNCH
  unsigned my_xcc = 0, my_rank = 0;
  if (threadIdx.x == 0) { my_xcc = (unsigned)__builtin_amdgcn_s_getreg((3 << 11) | 20) & 7u; my_rank = __hip_atomic_fetch_add(bar + 8 + my_xcc, 1u, __ATOMIC_RELAXED, __HIP_MEMORY_SCOPE_AGENT); }
#endif
  int ph = 0;
#define PHASE(body) do { if (ph >= p.ph_lo && ph < p.ph_hi) { body; if (ph + 1 < p.ph_hi) GSYNC(); } ++ph; } while (0)
  PHASE(phase_prologue(p, lds));
#if !MULTI_LAUNCH
  {
    int* vsh = (int*)(lds + LDS_BYTES - 16);
    if (threadIdx.x == 0) { bool ok = true; for (int i = 0; i < 8; ++i) ok = ok && (__hip_atomic_load(bar + 8 + i, __ATOMIC_RELAXED, __HIP_MEMORY_SCOPE_AGENT) == 32u);
      *vsh = (ok && my_rank < 32u) ? (int)(my_xcc + 8u * my_rank) : (int)blockIdx.x; }
    __syncthreads(); vid = __builtin_amdgcn_readfirstlane(*vsh); __syncthreads();
  }
#endif
  for (int g = 0; g < 2; ++g) {
    PHASE(phase_gemm1_new(p, g, lds, vid));
    PHASE({ phase_conv(p, g, lds); phase_attn(p, g, lds, vid); });
    PHASE({ unsigned* pw = (unsigned*)(p.ws + OFF_BAR); const int pm_ = 8 * (vid & 7) + ((vid >> 3) & 7);
            phase_gemm2(p, lds, vid); panel_arrive(pw + 64 + 64 * g + pm_); panel_wait(pw + 64 + 64 * g + pm_, 4u);
            phase_gemm3_new(p, g, lds, vid); panel_arrive(pw + 192 + 64 * g + pm_); panel_wait(pw + 192 + 64 * g + pm_, 4u);
            phase_ln_panel(p, g, vid); });
  }
}
constexpr int N_PHASES = 7;

extern "C" void kernel_launch(void* const* d_in, const int* in_sizes, int n_in, void* d_out, int out_size, void* d_ws, size_t ws_size, hipStream_t stream) {
  static int grid = 0;
  if (grid == 0) {
    if (n_in != 20 || ws_size < WS_END || out_size != 2 * TG * DM) { fprintf(stderr, "kernel_launch: unexpected shapes n_in %d ws %zu out %d\n", n_in, ws_size, out_size); grid = -1; return; }
    int dev = 0, cus = 0, per_cu = 0;
    hipGetDevice(&dev); hipDeviceGetAttribute(&cus, hipDeviceAttributeMultiprocessorCount, dev);
    if (hipFuncSetAttribute((const void*)fwd_kernel, hipFuncAttributeMaxDynamicSharedMemorySize, LDS_BYTES) != hipSuccess) { fprintf(stderr, "kernel_launch: LDS attribute failed\n"); grid = -1; return; }
    hipOccupancyMaxActiveBlocksPerMultiprocessor(&per_cu, (const void*)fwd_kernel, NTHR, LDS_BYTES);
    if (per_cu < 1) { fprintf(stderr, "kernel_launch: occupancy query says %d\n", per_cu); per_cu = 1; }
    grid = cus;
    if (grid != 256) { fprintf(stderr, "kernel_launch: built for 256 CUs, found %d\n", grid); grid = 256; }
  }
  if (grid < 0) return;
  Params p{};
  p.x[0] = (const float*)d_in[0]; p.x[1] = (const float*)d_in[1];
  p.w_in = (const float*)d_in[2]; p.b_in = (const float*)d_in[3]; p.conv_dw = (const float*)d_in[4]; p.conv_dw_b = (const float*)d_in[5];
  p.conv_ln_g = (const float*)d_in[6]; p.conv_ln_b = (const float*)d_in[7]; p.w_cp = (const float*)d_in[8]; p.b_cp = (const float*)d_in[9];
  p.lq1 = (const float*)d_in[10]; p.lk1 = (const float*)d_in[11]; p.lq2 = (const float*)d_in[12]; p.lk2 = (const float*)d_in[13];
  p.subln_g = (const float*)d_in[14]; p.w_ao = (const float*)d_in[15]; p.w_out = (const float*)d_in[16]; p.b_out = (const float*)d_in[17];
  p.ln_g = (const float*)d_in[18]; p.ln_b = (const float*)d_in[19];
  p.out = (float*)d_out; p.ws = (unsigned char*)d_ws;
  for (int i = 0; i < 32; ++i) p.inv_freq_pi[i] = pow(10000.0, -(double)i / 32.0) / 3.14159265358979323846;
#if MULTI_LAUNCH
  for (int ph = 0; ph < N_PHASES; ++ph) { p.ph_lo = ph; p.ph_hi = ph + 1; hipLaunchKernelGGL(fwd_kernel, dim3(grid), dim3(NTHR), LDS_BYTES, stream, p); }
#else
  p.ph_lo = 0; p.ph_hi = N_PHASES;
  if (hipMemsetAsync((unsigned char*)d_ws + OFF_BAR, 0, 4096, stream) != hipSuccess) { fprintf(stderr, "kernel_launch: memset failed\n"); return; }
  void* args[] = {&p};
  hipError_t e = hipLaunchCooperativeKernel((const void*)fwd_kernel, dim3(grid), dim3(NTHR), args, LDS_BYTES, stream);
  if (e != hipSuccess) fprintf(stderr, "kernel_launch: cooperative launch failed: %s\n", hipGetErrorString(e));
#endif
}
```

```cpp
#include <hip/hip_runtime.h>
#include <hip/hip_cooperative_groups.h>
#include <cstdint>
#include <cstdio>
#include <cmath>
namespace cg = cooperative_groups;

#ifndef MULTI_LAUNCH
#define MULTI_LAUNCH 0
#endif

typedef unsigned short bf16_t;
typedef short bf16x8 __attribute__((ext_vector_type(8)));
typedef short s16x4 __attribute__((ext_vector_type(4)));
typedef float f32x16 __attribute__((ext_vector_type(16)));
typedef float f32x4 __attribute__((ext_vector_type(4)));
typedef float f32x2 __attribute__((ext_vector_type(2)));
typedef unsigned u32x4 __attribute__((ext_vector_type(4)));
typedef unsigned u32x2 __attribute__((ext_vector_type(2)));

constexpr int DM = 1024, TG = 16384, NV = 5632, NTHR = 512;
constexpr float LN_EPS = 1e-5f;
constexpr float ALPHA = 1.189207115002721f;
constexpr float LAM_INIT = 0.2f;
constexpr float QSCALE = 0.125f * 1.4426950408889634f;

constexpr size_t OFF_WIN = 0;
constexpr size_t OFF_WCP = OFF_WIN + (size_t)NV * 1024 * 2;
constexpr size_t OFF_WAO = OFF_WCP + (size_t)1024 * 512 * 2;
constexpr size_t OFF_WOUT = OFF_WAO + (size_t)1024 * 512 * 2;
constexpr size_t OFF_BIASV = OFF_WOUT + (size_t)1024 * 1024 * 2;
constexpr size_t OFF_ROPE = OFF_BIASV + 32768;
constexpr size_t OFF_MISC = OFF_ROPE + (size_t)16384 * 32 * 8;
constexpr size_t OFF_XB = OFF_MISC + 256;
constexpr size_t OFF_U = OFF_XB + (size_t)TG * 1024 * 2;
constexpr size_t OFF_CG = OFF_U + (size_t)TG * 512 * 2;
constexpr size_t OFF_Q = OFF_CG + (size_t)TG * 512 * 2;
constexpr size_t OFF_K = OFF_Q + (size_t)TG * 512 * 2;
constexpr size_t OFF_V = OFF_K + (size_t)TG * 512 * 2;
constexpr size_t OFF_AG = OFF_V + (size_t)TG * 512 * 2;
constexpr size_t OFF_MC = OFF_AG + (size_t)TG * 512 * 2;
constexpr size_t OFF_MA = OFF_MC + (size_t)TG * 1024 * 2;
constexpr size_t OFF_U2 = OFF_MA + (size_t)TG * 1024 * 2;
constexpr size_t OFF_O2 = OFF_U2 + (size_t)TG * 512 * 2;
constexpr size_t OFF_BAR = OFF_O2 + (size_t)TG * 512 * 2;
constexpr size_t OFF_XBAR = OFF_BAR + 4096;
constexpr size_t WS_END = OFF_XBAR + 16384;
static_assert(WS_END <= (size_t)256 * 1024 * 1024, "workspace over 256 MiB");
constexpr int LDS_BYTES = 131072 + 4096;

struct Params {
  const float* x[2];
  const float *w_in, *b_in, *conv_dw, *conv_dw_b, *conv_ln_g, *conv_ln_b, *w_cp, *b_cp, *lq1, *lk1, *lq2, *lk2, *subln_g, *w_ao, *w_out, *b_out, *ln_g, *ln_b;
  float* out;
  unsigned char* ws;
  double inv_freq_pi[32];
  int ph_lo, ph_hi;
};

__device__ __forceinline__ unsigned cvtpk(float lo, float hi) {
  unsigned r; asm volatile("v_cvt_pk_bf16_f32 %0, %1, %2" : "=v"(r) : "v"(lo), "v"(hi)); return r;
}
__device__ __forceinline__ float bf2f(unsigned short b) { return __uint_as_float(((unsigned)b) << 16); }
__device__ __forceinline__ float bflo(unsigned w) { return __uint_as_float(w << 16); }
__device__ __forceinline__ float bfhi(unsigned w) { return __uint_as_float(w & 0xffff0000u); }
__device__ __forceinline__ float sigmoidf_(float x) { return __builtin_amdgcn_rcpf(1.f + __expf(-x)); }
__device__ __forceinline__ float siluf_(float x) { return x * sigmoidf_(x); }
__device__ __forceinline__ int crow(int r, int hi) { return (r & 3) + 8 * (r >> 2) + 4 * hi; }
#define SBAR() __builtin_amdgcn_sched_barrier(0)
__device__ __forceinline__ int otid() { int t = threadIdx.x; asm volatile("" : "+v"(t)); return t; }

__device__ __forceinline__ int win_actual(int v) {
  if (v < 1024) { int b = v >> 5, h = (v >> 4) & 1, r = v & 15; int ch = 16 * b + 8 * h + (r & 7); return (r < 8) ? ch : 512 + ch; }
  if (v < 1536) return v;
  if (v < 2560) { int base = (v < 2048) ? 1536 : 2048; int j = v - base; int b = j >> 5, h = (j >> 4) & 1, r = j & 15; int g = b >> 1, sub = b & 1;
    int d = 16 * sub + 8 * h + (r & 7); return base + 64 * g + d + ((r >= 8) ? 32 : 0); }
  return v;
}

__device__ __forceinline__ void cvt_batch(const Params& p, int bi) {
  const float* __restrict__ src = p.x[bi >> 2];
  bf16_t* __restrict__ dst = (bi < 4) ? (bf16_t*)(p.ws + OFF_XB) : (bf16_t*)((unsigned char*)p.out + (size_t)TG * DM * 4);
  const long gn = (long)gridDim.x * NTHR, i = (long)blockIdx.x * NTHR + threadIdx.x + (long)(bi & 3) * 4 * gn;
  f32x4 a[4], b[4];
#pragma unroll
  for (int u = 0; u < 4; ++u) { a[u] = __builtin_nontemporal_load((const f32x4*)(src + (i + u * gn) * 8)); b[u] = __builtin_nontemporal_load((const f32x4*)(src + (i + u * gn) * 8 + 4)); }
#pragma unroll
  for (int u = 0; u < 4; ++u) { u32x4 w = {cvtpk(a[u][0], a[u][1]), cvtpk(a[u][2], a[u][3]), cvtpk(b[u][0], b[u][1]), cvtpk(b[u][2], b[u][3])};
    *(u32x4*)(dst + (i + u * gn) * 8) = w; }
}
__device__ __forceinline__ void transpose_tile(const Params& p, int bi, const float* __restrict__ src, int NS, int K, bf16_t* __restrict__ dst, bool mapped, int vt, int kt, char* lds) {
  float* tl = (float*)lds;
  const int tid = threadIdx.x;
  float r[8];
  const int j = tid & 63, v = vt * 64 + j, col = mapped ? win_actual(v) : v;
#pragma unroll
  for (int i = 0; i < 8; ++i) { const int kk = (tid >> 6) + 8 * i; r[i] = src[(long)(kt * 64 + kk) * NS + col]; }
  cvt_batch(p, bi);
  __syncthreads();
#pragma unroll
  for (int i = 0; i < 8; ++i) { const int kk = (tid >> 6) + 8 * i; tl[j * 65 + kk] = r[i]; }
  __syncthreads();
  { const int jj = tid >> 3, kc = (tid & 7) * 8; const float* q = tl + jj * 65 + kc;
    u32x4 w = {cvtpk(q[0], q[1]), cvtpk(q[2], q[3]), cvtpk(q[4], q[5]), cvtpk(q[6], q[7])};
    *(u32x4*)(dst + (long)(vt * 64 + jj) * K + kt * 64 + kc) = w; }
}

__device__ __forceinline__ int vperm(int p) { return 16 * ((p >> 2) & 1) + (p & 3) + 4 * (p >> 3); }
template <int NI>
__device__ __forceinline__ void gemm_loop(const bf16_t* __restrict__ A, int lda, const bf16_t* __restrict__ B, int ldb, int KT, char* lds, f32x16 (&acc)[4][NI]) {
  constexpr int A_BYTES = 256 * 128, B_BYTES = 128 * NI * 128, STAGE = A_BYTES + B_BYTES;
  const int tid = otid(), wid = tid >> 6, lane = tid & 63, wr = wid >> 2, wc = wid & 3, r32 = lane & 31, hi = lane >> 5;
  const int wbase_ = __builtin_amdgcn_readfirstlane(wid) * 64;
  const bf16_t* ga[4]; const bf16_t* gb[2 * NI];
#pragma unroll
  for (int i = 0; i < 4; ++i) { int q = i * NTHR + tid, R = q >> 3, pc = q & 7, c = pc ^ ((R >> 1) & 7); ga[i] = A + (long)R * lda + c * 8; }
#pragma unroll
  for (int i = 0; i < 2 * NI; ++i) { int q = i * NTHR + tid, R = q >> 3, pc = q & 7, c = pc ^ ((R >> 1) & 7); int Rg = (R & ~31) + vperm(R & 31); gb[i] = B + (long)Rg * ldb + c * 8; }
  const int sw = (r32 >> 1) & 7;
  int xo[4];
#pragma unroll
  for (int ks = 0; ks < 4; ++ks) xo[ks] = r32 * 128 + (((2 * ks + hi) ^ sw) << 4);
  const int a_base = (128 * wr) * 128, b_base = A_BYTES + (32 * NI * wc) * 128;
#define GL_A(sb_, i, kt) __builtin_amdgcn_global_load_lds((const unsigned*)(ga[i] + (kt) * 64), (unsigned*)((sb_) + ((i) * NTHR + wbase_) * 16), 16, 0, 0)
#define GL_B(sb_, i, kt) __builtin_amdgcn_global_load_lds((const unsigned*)(gb[i] + (kt) * 64), (unsigned*)((sb_) + A_BYTES + ((i) * NTHR + wbase_) * 16), 16, 0, 0)
  {
#pragma unroll
    for (int i = 0; i < 4; ++i) GL_A(lds, i, 0);
#pragma unroll
    for (int i = 0; i < 2 * NI; ++i) GL_B(lds, i, 0);
  }
#pragma unroll 1
  for (int kt = 0; kt < KT; ++kt) {
    asm volatile("s_waitcnt vmcnt(0)" ::: "memory");
    __syncthreads();
    const bool more = kt + 1 < KT;
    char* sn = lds + ((kt + 1) & 1) * STAGE;
    const char* sb = lds + (kt & 1) * STAGE;
    bf16x8 af[2][4], bfr[2][NI];
#define FRAG_RD(S, ks) do { _Pragma("unroll") for (int ni = 0; ni < NI; ++ni) bfr[S][ni] = *(const bf16x8*)(sb + b_base + ni * 4096 + xo[ks]);   \
                            _Pragma("unroll") for (int mi = 0; mi < 4; ++mi) af[S][mi] = *(const bf16x8*)(sb + a_base + mi * 4096 + xo[ks]); } while (0)
    FRAG_RD(0, 0);
#pragma unroll
    for (int ks = 0; ks < 4; ++ks) {
      const int cs = ks & 1;
      if (ks < 3) { if (cs == 0) FRAG_RD(1, ks + 1); else FRAG_RD(0, ks + 1); }
      SBAR();
#pragma unroll
      for (int mi = 0; mi < 2; ++mi)
#pragma unroll
        for (int ni = 0; ni < NI; ++ni) acc[mi][ni] = __builtin_amdgcn_mfma_f32_32x32x16_bf16(bfr[cs][ni], af[cs][mi], acc[mi][ni], 0, 0, 0);
      SBAR();
      if (more) { GL_A(sn, ks, kt + 1); if (NI == 2) { GL_B(sn, ks, kt + 1); } else if (ks < 2) { GL_B(sn, ks, kt + 1); } }
      SBAR();
#pragma unroll
      for (int mi = 2; mi < 4; ++mi)
#pragma unroll
        for (int ni = 0; ni < NI; ++ni) acc[mi][ni] = __builtin_amdgcn_mfma_f32_32x32x16_bf16(bfr[cs][ni], af[cs][mi], acc[mi][ni], 0, 0, 0);
    }
#undef FRAG_RD
  }
#undef GL_A
#undef GL_B
}

#define ST8(ptr, V, O) do { u32x4 w_ = {cvtpk(V[(O) + 0], V[(O) + 1]), cvtpk(V[(O) + 2], V[(O) + 3]), cvtpk(V[(O) + 4], V[(O) + 5]), cvtpk(V[(O) + 6], V[(O) + 7])}; *(u32x4*)(ptr) = w_; } while (0)

struct G1Ptrs { bf16_t *U, *CGb, *Qb, *Kb, *Vb, *AGb, *MCb, *MAb; const f32x2* rope; const float* biasv; int seqmask; };
template <int KIND>
__device__ __forceinline__ void g1_block(const f32x16& a, const G1Ptrs& P, int row, int vc0, int hi) {
  float v[16];
#pragma unroll
  for (int j = 0; j < 4; ++j) { f32x4 b4 = *(const f32x4*)(P.biasv + vc0 + 4 * j); v[4 * j] = a[4 * j] + b4[0]; v[4 * j + 1] = a[4 * j + 1] + b4[1]; v[4 * j + 2] = a[4 * j + 2] + b4[2]; v[4 * j + 3] = a[4 * j + 3] + b4[3]; }
  if constexpr (KIND == 0) {
    float o[8];
#pragma unroll
    for (int j = 0; j < 8; ++j) o[j] = v[j] * sigmoidf_(v[8 + j]);
    ST8(P.U + (long)row * 512 + (vc0 >> 1), o, 0);
  } else if constexpr (KIND == 1 || KIND == 5) {
    float o[16];
#pragma unroll
    for (int j = 0; j < 16; ++j) o[j] = siluf_(v[j]);
    bf16_t* d = (KIND == 1) ? (P.CGb + (long)row * 512 + (vc0 - 1024)) : (P.AGb + (long)row * 512 + (vc0 - 3072)); ST8(d, o, 0); ST8(d + 8, o, 8);
  } else if constexpr (KIND == 2 || KIND == 3) {
    constexpr bool isq = (KIND == 2); const int j0 = vc0 - (isq ? 1536 : 2048);
    const int b = j0 >> 5, gq = b >> 1, sub = b & 1, d0 = 16 * sub + 8 * hi;
    const int pos = row & P.seqmask;
    const f32x2* cs = P.rope + (long)pos * 32 + d0;
    float o1[8], o2[8]; constexpr float sc = isq ? QSCALE : 1.f;
#pragma unroll
    for (int j = 0; j < 4; ++j) { f32x4 c2 = *(const f32x4*)(cs + 2 * j);
      o1[2 * j] = (v[2 * j] * c2[0] - v[8 + 2 * j] * c2[1]) * sc; o2[2 * j] = (v[8 + 2 * j] * c2[0] + v[2 * j] * c2[1]) * sc;
      o1[2 * j + 1] = (v[2 * j + 1] * c2[2] - v[9 + 2 * j] * c2[3]) * sc; o2[2 * j + 1] = (v[9 + 2 * j] * c2[2] + v[2 * j + 1] * c2[3]) * sc; }
    bf16_t* d = (isq ? P.Qb : P.Kb) + (long)row * 512 + 64 * gq + d0; ST8(d, o1, 0); ST8(d + 32, o2, 0);
  } else if constexpr (KIND == 4) {
    bf16_t* d = P.Vb + (long)row * 512 + (vc0 - 2560); ST8(d, v, 0); ST8(d + 8, v, 8);
  } else {
    float o[16];
#pragma unroll
    for (int j = 0; j < 16; ++j) o[j] = sigmoidf_(v[j]);
    bf16_t* d = (KIND == 6) ? (P.MCb + (long)row * 1024 + (vc0 - 3584)) : (P.MAb + (long)row * 1024 + (vc0 - 4608)); ST8(d, o, 0); ST8(d + 8, o, 8);
  }
}
template <int KIND>
__device__ __forceinline__ void g1_epi(const f32x16 (&acc)[4][2], const G1Ptrs& P, int row0, int vcb, int hi) {
#define G1B(mi, ni) g1_block<KIND>(acc[mi][ni], P, row0 + 32 * (mi), vcb + 32 * (ni), hi); SBAR();
  G1B(0, 0) G1B(1, 0) G1B(2, 0) G1B(3, 0) G1B(0, 1) G1B(1, 1) G1B(2, 1) G1B(3, 1)
#undef G1B
}
__device__ __forceinline__ void phase_gemm1(const Params& p, int g, char* lds, int vid) {
  unsigned char* ws = p.ws;
  const bf16_t* Xb = (g == 0) ? (const bf16_t*)(ws + OFF_XB) : (const bf16_t*)((unsigned char*)p.out + (size_t)TG * DM * 4);
  const bf16_t* W = (const bf16_t*)(ws + OFF_WIN);
  G1Ptrs P;
  P.biasv = (const float*)(ws + OFF_BIASV); P.rope = (const f32x2*)(ws + OFF_ROPE);
  P.U = (bf16_t*)(ws + OFF_U); P.CGb = (bf16_t*)(ws + OFF_CG); P.Qb = (bf16_t*)(ws + OFF_Q); P.Kb = (bf16_t*)(ws + OFF_K);
  P.Vb = (bf16_t*)(ws + OFF_V); P.AGb = (bf16_t*)(ws + OFF_AG); P.MCb = (bf16_t*)(ws + OFF_MC); P.MAb = (bf16_t*)(ws + OFF_MA);
  P.seqmask = (g == 0) ? 16383 : 8191;
  const int tid = otid(), wid = tid >> 6, lane = tid & 63, wr = wid >> 2, wc = wid & 3, r32 = lane & 31, hi = lane >> 5;
  const int xg = vid & 7, jl = vid >> 3;
  for (int rnd = 0; rnd < 5; ++rnd) {
    int pm = 8 * xg + (jl & 7); const int pn = rnd * 4 + (jl >> 3);
    asm volatile("" : "+s"(pm));
    f32x16 acc[4][2];
#pragma unroll
    for (int mi = 0; mi < 4; ++mi)
#pragma unroll
      for (int ni = 0; ni < 2; ++ni) acc[mi][ni] = f32x16{};
    gemm_loop<2>(Xb + (long)pm * 256 * DM, DM, W + (long)pn * 256 * DM, DM, DM / 64, lds, acc);
    const int row0 = pm * 256 + 128 * wr + r32, vcb = pn * 256 + 64 * wc + 16 * hi;
    if (pn < 4) g1_epi<0>(acc, P, row0, vcb, hi);
    else if (pn < 6) g1_epi<1>(acc, P, row0, vcb, hi);
    else if (pn < 8) g1_epi<2>(acc, P, row0, vcb, hi);
    else if (pn < 10) g1_epi<3>(acc, P, row0, vcb, hi);
    else if (pn < 12) g1_epi<4>(acc, P, row0, vcb, hi);
    else if (pn < 14) g1_epi<5>(acc, P, row0, vcb, hi);
    else if (pn < 18) g1_epi<6>(acc, P, row0, vcb, hi);
    else g1_epi<7>(acc, P, row0, vcb, hi);
  }
  {
    int pm = 8 * xg + (jl & 7); const int n0 = 20 * 256 + 128 * (jl >> 3);
    asm volatile("" : "+s"(pm));
    f32x16 acc1[4][1];
#pragma unroll
    for (int mi = 0; mi < 4; ++mi) acc1[mi][0] = f32x16{};
    gemm_loop<1>(Xb + (long)pm * 256 * DM, DM, W + (long)n0 * DM, DM, DM / 64, lds, acc1);
    const int row0 = pm * 256 + 128 * wr + r32, vc0 = n0 + 32 * wc + 16 * hi;
    g1_block<7>(acc1[0][0], P, row0, vc0, hi); SBAR();
    g1_block<7>(acc1[1][0], P, row0 + 32, vc0, hi); SBAR();
    g1_block<7>(acc1[2][0], P, row0 + 64, vc0, hi); SBAR();
    g1_block<7>(acc1[3][0], P, row0 + 96, vc0, hi); SBAR();
  }
}

__device__ __forceinline__ void phase_conv(const Params& p, int g, char* lds) {
  unsigned char* ws = p.ws;
  const bf16_t* U = (const bf16_t*)(ws + OFF_U); const bf16_t* CGb = (const bf16_t*)(ws + OFF_CG); bf16_t* U2 = (bf16_t*)(ws + OFF_U2);
  const int tid = otid(), wid = tid >> 6, lane = tid & 63;
  const int seqlen = (g == 0) ? 16384 : 8192;
  unsigned* IN = (unsigned*)lds;
  float* OUT = (float*)(lds + 65536);
  const int cp = tid & 255, half = tid >> 8;
  float w0[31], w1[31];
#pragma unroll
  for (int j = 0; j < 31; ++j) { f32x2 w = *(const f32x2*)(p.conv_dw + j * 512 + 2 * cp); w0[j] = w[0]; w1[j] = w[1]; }
  const f32x2 cb = *(const f32x2*)(p.conv_dw_b + 2 * cp);
  for (int t = blockIdx.x; t < TG / 32; t += gridDim.x) {
    const int t0 = t * 32, slo = t0 & ~(seqlen - 1), shi = slo + seqlen;
    __syncthreads();
    for (int q = tid; q < 62 * 64; q += NTHR) { int r = q >> 6, c = q & 63; int tok = t0 - 15 + r; u32x4 v = {0u, 0u, 0u, 0u};
      if (tok >= slo && tok < shi) v = *(const u32x4*)(U + (long)tok * 512 + c * 8);
      *(u32x4*)(IN + r * 256 + c * 4) = v; }
    __syncthreads();
    float a0[16], a1[16];
#pragma unroll
    for (int i = 0; i < 16; ++i) { a0[i] = cb[0]; a1[i] = cb[1]; }
#pragma unroll
    for (int ti = 0; ti < 46; ++ti) {
      const unsigned w = IN[(16 * half + ti) * 256 + cp]; const float x0 = bflo(w), x1 = bfhi(w);
#pragma unroll
      for (int to = 0; to < 16; ++to) { const int j = ti - to; if (j >= 0 && j <= 30) { a0[to] = fmaf(w0[j], x0, a0[to]); a1[to] = fmaf(w1[j], x1, a1[to]); } }
    }
#pragma unroll
    for (int to = 0; to < 16; ++to) *(f32x2*)(OUT + (16 * half + to) * 512 + 2 * cp) = f32x2{a0[to], a1[to]};
    __syncthreads();
#pragma unroll
    for (int i = 0; i < 4; ++i) {
      const int tl = wid * 4 + i; const float* src = OUT + tl * 512 + lane * 8;
      f32x4 xa = *(const f32x4*)src, xb = *(const f32x4*)(src + 4);
      float x[8] = {xa[0], xa[1], xa[2], xa[3], xb[0], xb[1], xb[2], xb[3]};
      float s = 0.f;
#pragma unroll
      for (int j = 0; j < 8; ++j) s += x[j];
#pragma unroll
      for (int m = 1; m < 64; m <<= 1) s += __shfl_xor(s, m);
      const float mean = s * (1.f / 512.f); float q = 0.f;
#pragma unroll
      for (int j = 0; j < 8; ++j) { x[j] -= mean; q += x[j] * x[j]; }
#pragma unroll
      for (int m = 1; m < 64; m <<= 1) q += __shfl_xor(q, m);
      const float rstd = rsqrtf(q * (1.f / 512.f) + LN_EPS);
      const long tok = t0 + tl;
      f32x4 g0 = *(const f32x4*)(p.conv_ln_g + lane * 8), g1 = *(const f32x4*)(p.conv_ln_g + lane * 8 + 4);
      f32x4 b0 = *(const f32x4*)(p.conv_ln_b + lane * 8), b1 = *(const f32x4*)(p.conv_ln_b + lane * 8 + 4);
      const float gg[8] = {g0[0], g0[1], g0[2], g0[3], g1[0], g1[1], g1[2], g1[3]}, bb[8] = {b0[0], b0[1], b0[2], b0[3], b1[0], b1[1], b1[2], b1[3]};
      u32x4 cgw = *(const u32x4*)(CGb + tok * 512 + lane * 8);
      const float cgv[8] = {bflo(cgw[0]), bfhi(cgw[0]), bflo(cgw[1]), bfhi(cgw[1]), bflo(cgw[2]), bfhi(cgw[2]), bflo(cgw[3]), bfhi(cgw[3])};
      float o[8];
#pragma unroll
      for (int j = 0; j < 8; ++j) o[j] = siluf_(x[j] * rstd * gg[j] + bb[j]) * cgv[j];
      ST8(U2 + tok * 512 + lane * 8, o, 0);
    }
  }
}

#define KSWZ(row, colB) ((row) * 256 + ((colB) ^ (((row) & 7) << 4)))
constexpr float ATHR = 11.5f;
constexpr int SHM_V = 64 * 128 * 2, SHM_K = 64 * 128 * 2;
__device__ __forceinline__ float vmax3(float a, float b, float c) { float r; asm("v_max3_f32 %0, %1, %2, %3" : "=v"(r) : "v"(a), "v"(b), "v"(c)); return r; }
__device__ __forceinline__ float sm_max_a(const f32x16& p0) {
  float pm = vmax3(p0[0], p0[1], p0[2]);
#pragma unroll
  for (int r = 3; r < 15; r += 2) pm = vmax3(pm, p0[r], p0[r + 1]);
  return pm;
}
template <bool FIRST>
__device__ __forceinline__ void sm_max_b(float pm, f32x16& p0, f32x16& p1, float& m_reg, float& alpha, f32x16& cinit) {
  float pmax = vmax3(pm, p0[15], p1[0]);
#pragma unroll
  for (int r = 1; r < 15; r += 2) pmax = vmax3(pmax, p1[r], p1[r + 1]);
  pmax = fmaxf(pmax, p1[15]);
  { auto rr = __builtin_amdgcn_permlane32_swap(__float_as_uint(pmax), __float_as_uint(pmax), false, false);
    pmax = fmaxf(__uint_as_float(rr[0]), __uint_as_float(rr[1])); }
  alpha = 1.f;
  if (FIRST || !__builtin_expect(__all(pmax <= ATHR), 1)) {
    const float delta = FIRST ? pmax : fmaxf(pmax, 0.f);
    alpha = __builtin_amdgcn_exp2f(-delta); m_reg += delta;
#pragma unroll
    for (int r = 0; r < 16; ++r) { p0[r] -= delta; p1[r] -= delta; cinit[r] = -m_reg; }
  }
}
__device__ __forceinline__ void sm_exp(f32x16& p) {
#pragma unroll
  for (int r = 0; r < 16; ++r) p[r] = __builtin_amdgcn_exp2f(p[r]);
}
__device__ __forceinline__ void finishSM(f32x16& p0, f32x16& p1, float alpha, float& l_reg, bf16x8& pa0, bf16x8& pa1, bf16x8& pa2, bf16x8& pa3) {
  float ps = 0, ps2 = 0;
#pragma unroll
  for (int r = 0; r < 16; ++r) { ps += p0[r]; ps2 += p1[r]; }
  ps += ps2;
  { auto rr = __builtin_amdgcn_permlane32_swap(__float_as_uint(ps), __float_as_uint(ps), false, false);
    ps = __uint_as_float(rr[0]) + __uint_as_float(rr[1]); }
  l_reg = l_reg * alpha + ps;
#define PK4(P, BASE, OUT) do { u32x4 w = {cvtpk(P[BASE + 0], P[BASE + 1]), cvtpk(P[BASE + 2], P[BASE + 3]), cvtpk(P[BASE + 4], P[BASE + 5]), cvtpk(P[BASE + 6], P[BASE + 7])}; \
    OUT = *reinterpret_cast<bf16x8*>(&w); } while (0)
  PK4(p0, 0, pa0); PK4(p0, 8, pa1); PK4(p1, 0, pa2); PK4(p1, 8, pa3);
#undef PK4
}
__device__ __forceinline__ void qkt(f32x16& p0, f32x16& p1, const char* Ks, const bf16x8* qr, int r32, int hi, int comp, const f32x16& cinit) {
#pragma unroll
  for (int d0 = 0; d0 < 4; ++d0) { int cb = (comp * 64 + d0 * 16 + hi * 8) * 2;
    bf16x8 b0 = *reinterpret_cast<const bf16x8*>(Ks + KSWZ(r32, cb));
    bf16x8 b1 = *reinterpret_cast<const bf16x8*>(Ks + KSWZ(32 + r32, cb));
    if (d0 == 0) { p0 = __builtin_amdgcn_mfma_f32_32x32x16_bf16(b0, qr[d0], cinit, 0, 0, 0); p1 = __builtin_amdgcn_mfma_f32_32x32x16_bf16(b1, qr[d0], cinit, 0, 0, 0); }
    else { p0 = __builtin_amdgcn_mfma_f32_32x32x16_bf16(b0, qr[d0], p0, 0, 0, 0); p1 = __builtin_amdgcn_mfma_f32_32x32x16_bf16(b1, qr[d0], p1, 0, 0, 0); } }
}
__device__ __forceinline__ int v_st(int k, int c) { const int kk = (k & ~0xC) | ((k & 4) << 1) | ((k & 8) >> 1); return ((kk >> 3) * 4 + (c >> 5)) * 512 + ((kk & 7) * 32 + (c & 31)) * 2; }
__device__ __forceinline__ int v_rd_base(int lane) { return ((lane & 3) << 3) | (((lane >> 2) & 3) << 6) | (((lane >> 4) & 1) << 5) | (((lane >> 5) & 1) << 8); }
constexpr int v_rd_off(int d0, int ks, int half) { return d0 * 512 + ks * 4096 + half * 2048; }
template <int OFF> __device__ __forceinline__ s16x4 tr_read(int vb) {
  s16x4 r; asm volatile("ds_read_b64_tr_b16 %0, %1 offset:%2" : "=&v"(r) : "v"(vb), "i"(OFF) : "memory"); return r;
}
template <int D0> __device__ __forceinline__ void pv_one(f32x16& od, int vb, bf16x8 pa0, bf16x8 pa1, bf16x8 pa2, bf16x8 pa3) {
  const s16x4 l0 = tr_read<v_rd_off(D0, 0, 0)>(vb), h0 = tr_read<v_rd_off(D0, 0, 1)>(vb), l1 = tr_read<v_rd_off(D0, 1, 0)>(vb), h1 = tr_read<v_rd_off(D0, 1, 1)>(vb);
  const s16x4 l2 = tr_read<v_rd_off(D0, 2, 0)>(vb), h2 = tr_read<v_rd_off(D0, 2, 1)>(vb), l3 = tr_read<v_rd_off(D0, 3, 0)>(vb), h3 = tr_read<v_rd_off(D0, 3, 1)>(vb);
  asm volatile("s_waitcnt lgkmcnt(0)" ::: "memory"); SBAR();
#define PK(L, H) (bf16x8){L[0], L[1], L[2], L[3], H[0], H[1], H[2], H[3]}
  od = __builtin_amdgcn_mfma_f32_32x32x16_bf16(pa0, PK(l0, h0), od, 0, 0, 0);
  od = __builtin_amdgcn_mfma_f32_32x32x16_bf16(pa1, PK(l1, h1), od, 0, 0, 0);
  od = __builtin_amdgcn_mfma_f32_32x32x16_bf16(pa2, PK(l2, h2), od, 0, 0, 0);
  od = __builtin_amdgcn_mfma_f32_32x32x16_bf16(pa3, PK(l3, h3), od, 0, 0, 0);
#undef PK
}

typedef float f32x2_t_ __attribute__((ext_vector_type(2))); typedef __bf16 bf16x2_t_ __attribute__((ext_vector_type(2)));
__device__ __forceinline__ unsigned cvtpk_s(float lo, float hi) { f32x2_t_ v = {lo, hi}; bf16x2_t_ b = __builtin_convertvector(v, bf16x2_t_); return __builtin_bit_cast(unsigned, b); }
typedef __attribute__((address_space(3))) const char* lds_cptr;
typedef short v4i16_t_ __attribute__((ext_vector_type(4)));
__device__ __forceinline__ s16x4 vtr(lds_cptr p) { return __builtin_bit_cast(s16x4, __builtin_amdgcn_ds_read_tr16_b64_v4i16((__attribute__((address_space(3))) v4i16_t_*)p)); }
__device__ __forceinline__ void attn_unit(const bf16_t* __restrict__ Qb, const bf16_t* __restrict__ Kh, const bf16_t* __restrict__ Vh, const bf16_t* __restrict__ AGb,
                                          bf16_t* __restrict__ O2b, int seq, float lam, const float* __restrict__ subg, char* lds) {
  constexpr int LDK = 512;
  const int tid = otid(), wid = tid >> 6, lane = tid & 63, r32 = lane & 31, hi = lane >> 5, rowgrp = wid & 3, comp = wid >> 2;
  constexpr int BUFB = SHM_V + SHM_K;
  float* wsl = (float*)(lds + 3 * BUFB) + wid * 64; float* li_l = wsl; float* al_l = wsl + 32;
  float m_reg = 0.f, l_reg = 0; f32x16 o[4] = {}; bf16x8 qr[4]; f32x16 cinit = {};
  const int vb0 = (int)(uintptr_t)lds + v_rd_base(lane);
  const int wid_s = __builtin_amdgcn_readfirstlane(wid);
  const bf16_t* ksrc[2]; const bf16_t* vsrc[2];
#pragma unroll
  for (int i = 0; i < 2; ++i) {
    const int pk = 2 * wid + i, row = 4 * pk + (lane >> 4), chunk = (lane & 15) ^ (row & 7);
    ksrc[i] = Kh + (long)row * LDK + chunk * 8;
    const int q = 64 * pk + lane, sti = q >> 5, kkl = (q >> 2) & 7, cq = q & 3, kk = (sti >> 2) * 8 + kkl, c = (sti & 3) * 32 + cq * 8, k = kk;
    vsrc[i] = Vh + (long)k * LDK + c;
  }
#define DMA_TILE(t, ob) do { char* d_ = lds + (ob) + wid_s * 2048; const long to_ = (long)(t) * 64 * LDK;                                  \
    __builtin_amdgcn_global_load_lds((const unsigned*)(vsrc[0] + to_), (unsigned*)(d_), 16, 0, 0);                                              \
    __builtin_amdgcn_global_load_lds((const unsigned*)(vsrc[1] + to_), (unsigned*)(d_ + 1024), 16, 0, 0);                                       \
    __builtin_amdgcn_global_load_lds((const unsigned*)(ksrc[0] + to_), (unsigned*)(d_ + SHM_V), 16, 0, 0);                                      \
    __builtin_amdgcn_global_load_lds((const unsigned*)(ksrc[1] + to_), (unsigned*)(d_ + SHM_V + 1024), 16, 0, 0); } while (0)
#define TILE_BAR() do { asm volatile("s_waitcnt vmcnt(0) lgkmcnt(0)" ::: "memory"); __builtin_amdgcn_s_barrier(); asm volatile("" ::: "memory"); } while (0)
#define RESC(a) do { if (__any((a) < 1.f)) { if (hi == 0) al_l[r32] = (a); asm volatile("s_waitcnt lgkmcnt(0)" ::: "memory"); \
    _Pragma("unroll") for (int d = 0; d < 4; ++d) _Pragma("unroll") for (int r = 0; r < 16; ++r) o[d][r] *= al_l[crow(r, hi)]; } } while (0)
  DMA_TILE(0, 0); DMA_TILE(1, BUFB);
  const bf16_t* Qw = Qb + (long)(rowgrp * 32 + r32) * LDK + comp * 64 + hi * 8;
#pragma unroll
  for (int d0 = 0; d0 < 4; ++d0) qr[d0] = *(const bf16x8*)(Qw + d0 * 16);
  f32x16 pA0, pA1, pB0, pB1; float alA, alB; bf16x8 pa0, pa1, pa2, pa3; const int NT = seq / 64;
  float pmx;
#define PV_SM(VB, P0, P1, AL) do {                                                                    \
    pv_one<0>(o[0], VB, pa0, pa1, pa2, pa3); pmx = sm_max_a(P0);                                       \
    pv_one<1>(o[1], VB, pa0, pa1, pa2, pa3); sm_max_b<false>(pmx, P0, P1, m_reg, AL, cinit);           \
    pv_one<2>(o[2], VB, pa0, pa1, pa2, pa3); sm_exp(P0);                                               \
    pv_one<3>(o[3], VB, pa0, pa1, pa2, pa3); sm_exp(P1); } while (0)
  TILE_BAR();
  qkt(pA0, pA1, lds + SHM_V, qr, r32, hi, comp, cinit); pmx = sm_max_a(pA0); sm_max_b<true>(pmx, pA0, pA1, m_reg, alA, cinit); alA = 1.f; sm_exp(pA0); sm_exp(pA1);
  int obp = 0, obc = BUFB, obn = 2 * BUFB;
  const int kx0 = r32 * 256 + ((comp * 128 + 0 * 32 + hi * 16) ^ ((r32 & 7) << 4)), kx1 = r32 * 256 + ((comp * 128 + 1 * 32 + hi * 16) ^ ((r32 & 7) << 4));
  const int kx2 = r32 * 256 + ((comp * 128 + 2 * 32 + hi * 16) ^ ((r32 & 7) << 4)), kx3 = r32 * 256 + ((comp * 128 + 3 * 32 + hi * 16) ^ ((r32 & 7) << 4));
  const int vrb = v_rd_base(lane);
#define PIN(x) asm volatile("" : "+v"(x))
#define MX3(a, b, c) __builtin_fmaxf(__builtin_fmaxf((a), (b)), (c))
#define KF(off) (*reinterpret_cast<const bf16x8*>(kb_ + (off)))
#define KP(p) (*reinterpret_cast<const bf16x8*>(p))
#define MF(a, b, c) __builtin_amdgcn_mfma_f32_32x32x16_bf16(a, b, c, 0, 0, 0)
#define VRD(i) do { vlo[i] = vtr(vp_ + v_rd_off((i) & 3, (i) >> 2, 0)); vhi[i] = vtr(vp_ + v_rd_off((i) & 3, (i) >> 2, 1)); } while (0)
#define VFR(i) (bf16x8){vlo[i][0], vlo[i][1], vlo[i][2], vlo[i][3], vhi[i][0], vhi[i][1], vhi[i][2], vhi[i][3]}
#define SWP(OUT) do { u32x4 w_ = {ca0, ca1, cb0, cb1}; OUT = *reinterpret_cast<bf16x8*>(&w_); } while (0)
#define GQA(MFS, P, B) do { MFS; sacc += P[B]; sacc += P[B + 1]; sacc += P[B + 2]; sacc += P[B + 3]; PIN(sacc); ca0 = cvtpk_s(P[B], P[B + 1]); ca1 = cvtpk_s(P[B + 2], P[B + 3]); PIN(ca0); PIN(ca1); SBAR(); } while (0)
#define GQB(MFS, P, B, OUT) do { MFS; sacc += P[B]; sacc += P[B + 1]; sacc += P[B + 2]; sacc += P[B + 3]; PIN(sacc); cb0 = cvtpk_s(P[B], P[B + 1]); cb1 = cvtpk_s(P[B + 2], P[B + 3]); SWP(OUT); PIN(OUT); SBAR(); } while (0)
#define GPM(i, PAk, X0, X1, X2, X3) do { if ((i) + 2 < 16) VRD((i) + 2); o[(i) & 3] = MF(PAk, VFR(i), o[(i) & 3]); rm_ = MX3(rm_, X0, X1); rm_ = MX3(rm_, X2, X3); PIN(rm_); SBAR(); } while (0)
#define GPE(i, PAk, X, B) do { if ((i) + 2 < 16) VRD((i) + 2); o[(i) & 3] = MF(PAk, VFR(i), o[(i) & 3]); X[B] = __builtin_amdgcn_exp2f(X[B]); X[B + 1] = __builtin_amdgcn_exp2f(X[B + 1]); \
    X[B + 2] = __builtin_amdgcn_exp2f(X[B + 2]); X[B + 3] = __builtin_amdgcn_exp2f(X[B + 3]); PIN(X); SBAR(); } while (0)
#define GPX(i, PAk, X, B) do { if ((i) + 2 < 16) VRD((i) + 2); o[(i) & 3] = MF(PAk, VFR(i), o[(i) & 3]); X[B] = __builtin_amdgcn_exp2f(X[B]); X[B + 1] = __builtin_amdgcn_exp2f(X[B + 1]); PIN(X); SBAR(); } while (0)
#define STEP(C0, C1, P0, P1, AL) do { SBAR();                                                                                    \
    const char* kb_ = lds + obc + SHM_V; const lds_cptr vp_ = (lds_cptr)lds + obp + vrb;                                            \
    s16x4 vlo[16], vhi[16]; unsigned ca0, ca1, cb0, cb1; float sacc = 0.f;                                                        \
    const char* k0_ = kb_ + kx0; const char* k1_ = kb_ + kx1; const char* k2_ = kb_ + kx2; const char* k3_ = kb_ + kx3;                 \
    const bf16x8 kf0 = KP(k0_), kf1 = KP(k0_ + 8192), kf2 = KP(k1_), kf3 = KP(k1_ + 8192); SBAR();                                \
    GQA(C0 = MF(kf0, qr[0], cinit), P0, 0);                                                                                       \
    const bf16x8 kf4 = KP(k2_), kf5 = KP(k2_ + 8192), kf6 = KP(k3_), kf7 = KP(k3_ + 8192);                                        \
    GQB(C1 = MF(kf1, qr[0], cinit), P0, 4, pa0);                                                                                  \
    GQA(C0 = MF(kf2, qr[1], C0), P0, 8);  GQB(C1 = MF(kf3, qr[1], C1), P0, 12, pa1);                                              \
    VRD(0);                                                                                                                       \
    GQA(C0 = MF(kf4, qr[2], C0), P1, 0);  GQB(C1 = MF(kf5, qr[2], C1), P1, 4, pa2);                                               \
    VRD(1);                                                                                                                       \
    GQA(C0 = MF(kf6, qr[3], C0), P1, 8);  GQB(C1 = MF(kf7, qr[3], C1), P1, 12, pa3);                                              \
    float ps_; { auto rr_ = __builtin_amdgcn_permlane32_swap(__float_as_uint(sacc), __float_as_uint(sacc), false, false);        \
      ps_ = __uint_as_float(rr_[0]) + __uint_as_float(rr_[1]); }                                                                  \
    l_reg += ps_; AL = 1.f;                                                                                                       \
    if (!__builtin_expect(__all(ps_ <= PTHR), 1)) { const float dl_ = fmaxf(__log2f(ps_), 0.f); AL = __builtin_amdgcn_exp2f(-dl_); m_reg += dl_;   \
      _Pragma("unroll") for (int r = 0; r < 16; ++r) { C0[r] -= dl_; C1[r] -= dl_; cinit[r] = -m_reg; } }                            \
    SBAR();                                                                                                                       \
    GPX(0, pa0, C0, 0);  GPX(1, pa0, C0, 2);  GPX(2, pa0, C0, 4);   GPX(3, pa0, C0, 6);                                           \
    GPX(4, pa1, C0, 8);  GPX(5, pa1, C0, 10); GPX(6, pa1, C0, 12);  GPX(7, pa1, C0, 14);                                          \
    GPX(8, pa2, C1, 0);  GPX(9, pa2, C1, 2);  GPX(10, pa2, C1, 4);  GPX(11, pa2, C1, 6);                                          \
    GPX(12, pa3, C1, 8); GPX(13, pa3, C1, 10); GPX(14, pa3, C1, 12); GPX(15, pa3, C1, 14);                                        \
    if (__any(AL < 1.f)) { if (hi == 0) al_l[r32] = AL; asm volatile("s_waitcnt lgkmcnt(0)" ::: "memory"); l_reg *= AL;          \
      _Pragma("unroll") for (int d = 0; d < 4; ++d) _Pragma("unroll") for (int r = 0; r < 16; ++r) o[d][r] *= al_l[crow(r, hi)]; } \
  } while (0)
  constexpr float PTHR = 2896.3f;
  { float alS;
  for (int j = 1; j + 1 < NT; j += 2) {
    DMA_TILE(j + 1, obn);
    STEP(pB0, pB1, pA0, pA1, alS);
    TILE_BAR();
    { const int t_ = obp; obp = obc; obc = obn; obn = t_; }
    if (j + 2 < NT) DMA_TILE(j + 2, obn);
    STEP(pA0, pA1, pB0, pB1, alS);
    TILE_BAR();
    { const int t_ = obp; obp = obc; obc = obn; obn = t_; }
  } }
  alA = 1.f;
#undef GPX
#undef STEP
#undef GPE
#undef GPM
#undef GQB
#undef GQA
#undef SWP
#undef VFR
#undef VRD
#undef MF
#undef KF
#undef KP
#undef PIN
#undef MX3
  SBAR(); qkt(pB0, pB1, lds + obc + SHM_V, qr, r32, hi, comp, cinit);
  finishSM(pA0, pA1, alA, l_reg, pa0, pa1, pa2, pa3); SBAR();
  PV_SM(vb0 + obp, pB0, pB1, alB);
  RESC(alB);
  finishSM(pB0, pB1, alB, l_reg, pa0, pa1, pa2, pa3); SBAR();
  pv_one<0>(o[0], vb0 + obc, pa0, pa1, pa2, pa3); pv_one<1>(o[1], vb0 + obc, pa0, pa1, pa2, pa3);
  pv_one<2>(o[2], vb0 + obc, pa0, pa1, pa2, pa3); pv_one<3>(o[3], vb0 + obc, pa0, pa1, pa2, pa3);
#undef PV_SM
#undef DMA_TILE
#undef TILE_BAR
#undef RESC
  asm volatile("s_waitcnt vmcnt(0)" ::: "memory");
  __syncthreads();
  float* X = (float*)lds;
  if (hi == 0) li_l[r32] = l_reg;
  asm volatile("s_waitcnt lgkmcnt(0)" ::: "memory");
  float rli[16];
#pragma unroll
  for (int r = 0; r < 16; ++r) rli[r] = __builtin_amdgcn_rcpf(li_l[crow(r, hi)]);
  if (comp == 0) {
#pragma unroll
    for (int r = 0; r < 16; ++r)
#pragma unroll
      for (int d0 = 0; d0 < 4; ++d0) X[(rowgrp * 32 + crow(r, hi)) * 128 + d0 * 32 + r32] = o[d0][r] * rli[r];
  }
  __syncthreads();
  if (comp == 1) {
#pragma unroll
    for (int r = 0; r < 16; ++r)
#pragma unroll
      for (int d0 = 0; d0 < 4; ++d0) { float* xp = X + (rowgrp * 32 + crow(r, hi)) * 128 + d0 * 32 + r32; *xp = *xp - lam * (o[d0][r] * rli[r]); }
  }
  __syncthreads();
  {
    const int row = tid >> 2, c0 = (tid & 3) * 32;
    float v[32]; float ss = 0.f;
#pragma unroll
    for (int i = 0; i < 8; ++i) { f32x4 x4 = *(const f32x4*)(X + row * 128 + c0 + 4 * i); v[4 * i] = x4[0]; v[4 * i + 1] = x4[1]; v[4 * i + 2] = x4[2]; v[4 * i + 3] = x4[3]; }
#pragma unroll
    for (int i = 0; i < 32; ++i) ss += v[i] * v[i];
    ss += __shfl_xor(ss, 1); ss += __shfl_xor(ss, 2);
    const float rs = rsqrtf(ss * (1.f / 128.f) + LN_EPS) * (1.f - LAM_INIT);
#pragma unroll
    for (int i = 0; i < 4; ++i) {
      u32x4 gw = *(const u32x4*)(AGb + (long)row * 512 + c0 + 8 * i);
      f32x4 s0 = *(const f32x4*)(subg + c0 + 8 * i), s1 = *(const f32x4*)(subg + c0 + 8 * i + 4);
      float ov[8];
      ov[0] = v[8 * i + 0] * rs * s0[0] * bflo(gw[0]); ov[1] = v[8 * i + 1] * rs * s0[1] * bfhi(gw[0]);
      ov[2] = v[8 * i + 2] * rs * s0[2] * bflo(gw[1]); ov[3] = v[8 * i + 3] * rs * s0[3] * bfhi(gw[1]);
      ov[4] = v[8 * i + 4] * rs * s1[0] * bflo(gw[2]); ov[5] = v[8 * i + 5] * rs * s1[1] * bfhi(gw[2]);
      ov[6] = v[8 * i + 6] * rs * s1[2] * bflo(gw[3]); ov[7] = v[8 * i + 7] * rs * s1[3] * bfhi(gw[3]);
      ST8(O2b + (long)row * 512 + c0 + 8 * i, ov, 0);
    }
  }
  __syncthreads();
}

__device__ __forceinline__ void phase_attn(const Params& p, int g, char* lds, int vid) {
  unsigned char* ws = p.ws;
  const bf16_t* Qb = (const bf16_t*)(ws + OFF_Q); const bf16_t* Kb = (const bf16_t*)(ws + OFF_K); const bf16_t* Vb = (const bf16_t*)(ws + OFF_V);
  const bf16_t* AGb = (const bf16_t*)(ws + OFF_AG); bf16_t* O2 = (bf16_t*)(ws + OFF_O2);
  const float lam = *(const float*)(ws + OFF_MISC);
  const int x = vid & 7, jj = vid >> 3, nper = 32;
  for (int u = jj; u < 64; u += nper) {
    int head, seq0, seq, qb;
    if (g == 0) { head = x >> 1; seq0 = 0; seq = 16384; qb = (x & 1) * 64 + u; }
    else { head = x & 3; seq0 = (x >> 2) * 8192; seq = 8192; qb = u; }
    const long qrow = seq0 + (long)qb * 128;
    attn_unit(Qb + qrow * 512 + head * 128, Kb + (long)seq0 * 512 + head * 128, Vb + (long)seq0 * 512 + head * 128, AGb + qrow * 512 + head * 128,
              O2 + qrow * 512 + head * 128, seq, lam, p.subln_g, lds);
  }
}

__device__ __forceinline__ void g2_block(const f32x16& a1, const f32x16& a2, const bf16_t* MCb, const bf16_t* MAb, bf16_t* MG, const float* bcp, long row, int c0) {
  u32x4 mc0 = *(const u32x4*)(MCb + row * 1024 + c0), mc1 = *(const u32x4*)(MCb + row * 1024 + c0 + 8);
  u32x4 ma0 = *(const u32x4*)(MAb + row * 1024 + c0), ma1 = *(const u32x4*)(MAb + row * 1024 + c0 + 8);
  float bc[16];
#pragma unroll
  for (int j = 0; j < 4; ++j) { f32x4 b4 = *(const f32x4*)(bcp + c0 + 4 * j); bc[4 * j] = b4[0]; bc[4 * j + 1] = b4[1]; bc[4 * j + 2] = b4[2]; bc[4 * j + 3] = b4[3]; }
  float o[16];
#pragma unroll
  for (int j = 0; j < 4; ++j) {
    o[2 * j] = bflo(mc0[j]) * (a1[2 * j] + bc[2 * j]) + bflo(ma0[j]) * a2[2 * j];
    o[2 * j + 1] = bfhi(mc0[j]) * (a1[2 * j + 1] + bc[2 * j + 1]) + bfhi(ma0[j]) * a2[2 * j + 1];
    o[8 + 2 * j] = bflo(mc1[j]) * (a1[8 + 2 * j] + bc[8 + 2 * j]) + bflo(ma1[j]) * a2[8 + 2 * j];
    o[8 + 2 * j + 1] = bfhi(mc1[j]) * (a1[8 + 2 * j + 1] + bc[8 + 2 * j + 1]) + bfhi(ma1[j]) * a2[8 + 2 * j + 1];
  }
  ST8(MG + row * 1024 + c0, o, 0); ST8(MG + row * 1024 + c0 + 8, o, 8);
}
__device__ __forceinline__ void phase_gemm2(const Params& p, char* lds, int vid) {
  unsigned char* ws = p.ws;
  const bf16_t* U2 = (const bf16_t*)(ws + OFF_U2); const bf16_t* O2 = (const bf16_t*)(ws + OFF_O2);
  const bf16_t* Wcp = (const bf16_t*)(ws + OFF_WCP); const bf16_t* Wao = (const bf16_t*)(ws + OFF_WAO);
  const bf16_t* MCb = (const bf16_t*)(ws + OFF_MC); const bf16_t* MAb = (const bf16_t*)(ws + OFF_MA); bf16_t* MG = (bf16_t*)(ws + OFF_XB);
  const int tid = otid(), wid = tid >> 6, lane = tid & 63, wr = wid >> 2, wc = wid & 3, r32 = lane & 31, hi = lane >> 5;
  const int xg = vid & 7, jl = vid >> 3;
  for (int rnd = 0; rnd < 2; ++rnd) {
    int pm = 8 * xg + (jl & 7); const int pn = rnd * 4 + (jl >> 3);
    asm volatile("" : "+s"(pm));
    f32x16 a1[4][1], a2[4][1];
#pragma unroll
    for (int mi = 0; mi < 4; ++mi) { a1[mi][0] = f32x16{}; a2[mi][0] = f32x16{}; }
    gemm_loop<1>(U2 + (long)pm * 256 * 512, 512, Wcp + (long)pn * 128 * 512, 512, 8, lds, a1);
    gemm_loop<1>(O2 + (long)pm * 256 * 512, 512, Wao + (long)pn * 128 * 512, 512, 8, lds, a2);
    const int c0 = pn * 128 + 32 * wc + 16 * hi;
    const long row0 = pm * 256 + 128 * wr + r32;
    g2_block(a1[0][0], a2[0][0], MCb, MAb, MG, p.b_cp, row0, c0); SBAR();
    g2_block(a1[1][0], a2[1][0], MCb, MAb, MG, p.b_cp, row0 + 32, c0); SBAR();
    g2_block(a1[2][0], a2[2][0], MCb, MAb, MG, p.b_cp, row0 + 64, c0); SBAR();
    g2_block(a1[3][0], a2[3][0], MCb, MAb, MG, p.b_cp, row0 + 96, c0); SBAR();
  }
}

__device__ __forceinline__ void phase_gemm3(const Params& p, int g, char* lds, int vid) {
  unsigned char* ws = p.ws;
  const bf16_t* MG = (const bf16_t*)(ws + OFF_XB); const bf16_t* Wo = (const bf16_t*)(ws + OFF_WOUT);
  const float* x = p.x[g]; float* out = p.out + (size_t)g * TG * DM;
  const int tid = otid(), wid = tid >> 6, lane = tid & 63, wr = wid >> 2, wc = wid & 3, r32 = lane & 31, hi = lane >> 5;
  const int xg = vid & 7, jl = vid >> 3;
  {
    const int pm = 8 * xg + (jl & 7), pn = (jl >> 3);
    f32x16 acc[4][2];
#pragma unroll
    for (int mi = 0; mi < 4; ++mi)
#pragma unroll
      for (int ni = 0; ni < 2; ++ni) acc[mi][ni] = f32x16{};
    gemm_loop<2>(MG + (long)pm * 256 * DM, DM, Wo + (long)pn * 256 * DM, DM, DM / 64, lds, acc);
#pragma unroll
    for (int ni = 0; ni < 2; ++ni) {
      const int c0 = pn * 256 + 64 * wc + 32 * ni + 16 * hi;
      f32x4 bo[4];
#pragma unroll
      for (int j = 0; j < 4; ++j) bo[j] = *(const f32x4*)(p.b_out + c0 + 4 * j);
#pragma unroll
      for (int mi = 0; mi < 4; ++mi) {
        const long row = pm * 256 + 128 * wr + 32 * mi + r32;
#pragma unroll
        for (int j = 0; j < 4; ++j) {
          f32x4 xv = *(const f32x4*)(x + row * DM + c0 + 4 * j); f32x4 r;
          r[0] = acc[mi][ni][4 * j] + bo[j][0] + ALPHA * xv[0]; r[1] = acc[mi][ni][4 * j + 1] + bo[j][1] + ALPHA * xv[1];
          r[2] = acc[mi][ni][4 * j + 2] + bo[j][2] + ALPHA * xv[2]; r[3] = acc[mi][ni][4 * j + 3] + bo[j][3] + ALPHA * xv[3];
          *(f32x4*)(out + row * DM + c0 + 4 * j) = r;
        }
      }
    }
  }
}

namespace pg8 {
#define PG8_LAS __attribute__((address_space(3)))
constexpr int BM = 256, BK = 64, HALF = 128, HTB = HALF * BK * 2, STAGE_BYTES = 8 * HTB;
__device__ __forceinline__ int lds_byte(int r, int c) { const int st = (r >> 4) * 2 + (c >> 5), rr = r & 15, cc = c & 31, ob = rr * 64 + cc * 2; return st * 1024 + (ob ^ (((ob >> 9) & 1) << 5)); }
__device__ __forceinline__ void stage_rc(int b, int& R, int& C) { const int st = b / 1024, sb = b % 1024, swz = sb ^ (((sb >> 9) & 1) << 5); R = (st >> 1) * 16 + swz / 64; C = (st & 1) * 32 + (swz % 64) / 2; }
__device__ __forceinline__ int perm32(int rho) { const int n = rho >> 4, i = rho & 15; return 8 * (i >> 2) + 4 * n + (i & 3); }
struct Unit { int pm, pn; };
struct Gemm { const bf16_t* A; const bf16_t* Bt; int M, N, K; };
struct GroupOrder {
  int xg, jl, npn;
  __device__ __forceinline__ bool next(int i, Unit& u) const { int pm_ = 8 * xg + (jl & 7); asm volatile("" : "+s"(pm_));
    u.pm = pm_; u.pn = 4 * i + (jl >> 3); return u.pn < npn; }
  __device__ __forceinline__ void a_ready(const Unit&) const {}
  __device__ __forceinline__ void done(const Unit&) const {}
};
template <class Epi, class Sched, bool ALIGN_EPI = false, bool SP2 = false>
__device__ __forceinline__ void gemm_phase(PG8_LAS unsigned char* lds, const Gemm g, const Sched& S, const Epi& E) {
    const int tid = otid(), wid = __builtin_amdgcn_readfirstlane(tid >> 6), lane = tid & 63, wr = wid >> 2, wc = wid & 3, fr = lane & 15, fq = lane >> 4;
    const int K = g.K, nt = K / BK;
    unsigned voffA[2], voffB[2];
#pragma unroll
    for (int i = 0; i < 2; ++i) { int R, C; stage_rc(tid * 16 + i * 8192, R, C); const int Rb = Epi::PERM ? ((R & ~31) + perm32(R & 31)) : R;
        voffA[i] = (unsigned)(R * K + C) * 2u; voffB[i] = (unsigned)(Rb * K + C) * 2u; }
    const size_t kstep = (size_t)(BK * 2);
    const size_t hstep = (size_t)HALF * K * 2;
    const size_t tstep = 2 * hstep;
    const unsigned ldsw = (unsigned)wid * 1024u;
    const int aoff = lds_byte(wr * 64 + fr, fq * 8), boff = lds_byte(wc * 32 + fr, fq * 8);
#define PG8_SA(b, h) (((b) * 2 + (h)) * HTB)
#define PG8_SB(b, h) ((4 + (b) * 2 + (h)) * HTB)
#define PG8_STAGE(bufoff, gbase, voff) do { _Pragma("unroll") for (int _i = 0; _i < 2; ++_i) \
        __builtin_amdgcn_global_load_lds((const unsigned*)((const char*)(gbase) + (voff)[_i]), (PG8_LAS unsigned*)(lds + (bufoff) + ldsw + _i * 8192), 16, 0, 0); } while (0)
#define PG8_LDA(dst, b, h) do { _Pragma("unroll") for (int m = 0; m < 4; ++m) _Pragma("unroll") for (int k = 0; k < 2; ++k) dst[m][k] = *(const PG8_LAS bf16x8*)(lds + PG8_SA(b, h) + aoff + m * 2048 + k * 1024); } while (0)
#define PG8_LDB(dst, b, h) do { _Pragma("unroll") for (int n = 0; n < 2; ++n) _Pragma("unroll") for (int k = 0; k < 2; ++k) dst[n][k] = *(const PG8_LAS bf16x8*)(lds + PG8_SB(b, h) + boff + n * 2048 + k * 1024); } while (0)
#define PG8_MMA(ai, bj, At, Bt) do { __builtin_amdgcn_s_setprio(1); _Pragma("unroll") for (int m = 0; m < 4; ++m) _Pragma("unroll") for (int n = 0; n < 2; ++n) _Pragma("unroll") for (int k = 0; k < 2; ++k) \
        acc[ai][bj][m][n] = __builtin_amdgcn_mfma_f32_16x16x32_bf16(Bt[n][k], At[m][k], acc[ai][bj][m][n], 0, 0, 0); __builtin_amdgcn_s_setprio(0); } while (0)
#define PG8_WAIT_V(n) asm volatile("s_waitcnt vmcnt(" #n ")" ::: "memory")
#define PG8_WAIT_L(n) asm volatile("s_waitcnt lgkmcnt(" #n ")" ::: "memory")
#define PG8_BAR __builtin_amdgcn_s_barrier()
#define PG8_SCHED __builtin_amdgcn_sched_barrier(0)
    Unit cur, nxt; int ui = 0;
    if (!S.next(0, cur)) return;
    f32x4 acc[2][2][4][2];
#pragma unroll
    for (int a = 0; a < 2; ++a)
#pragma unroll
        for (int b = 0; b < 2; ++b)
#pragma unroll
            for (int m = 0; m < 4; ++m)
#pragma unroll
                for (int n = 0; n < 2; ++n) acc[a][b][m][n] = (f32x4){0.f, 0.f, 0.f, 0.f};
    bf16x8 At[4][2], B0[2][2], B1[2][2];
    const char* cA = (const char*)g.A + (size_t)cur.pm * tstep; const char* cB = (const char*)g.Bt + (size_t)cur.pn * tstep;
    S.a_ready(cur);
    if constexpr (SP2) {
        PG8_STAGE(PG8_SB(0, 0), cB, voffB); PG8_STAGE(PG8_SB(0, 1), cB + hstep, voffB); PG8_STAGE(PG8_SA(0, 0), cA, voffA); PG8_STAGE(PG8_SA(0, 1), cA + hstep, voffA);
        if (wr == 1) PG8_BAR;
        PG8_WAIT_V(2); PG8_BAR;
        PG8_STAGE(PG8_SB(1, 0), cB + kstep, voffB); PG8_STAGE(PG8_SA(1, 0), cA + kstep, voffA); PG8_STAGE(PG8_SB(1, 1), cB + hstep + kstep, voffB);
        PG8_WAIT_V(6); PG8_BAR;
    } else {
        PG8_STAGE(PG8_SB(0, 0), cB, voffB); PG8_STAGE(PG8_SA(0, 0), cA, voffA); PG8_STAGE(PG8_SB(0, 1), cB + hstep, voffB); PG8_STAGE(PG8_SA(0, 1), cA + hstep, voffA);
        if (wr == 1) PG8_BAR;
        PG8_WAIT_V(4); PG8_BAR;
        PG8_STAGE(PG8_SB(1, 0), cB + kstep, voffB); PG8_STAGE(PG8_SA(1, 0), cA + kstep, voffA); PG8_STAGE(PG8_SB(1, 1), cB + hstep + kstep, voffB);
        PG8_WAIT_V(6); PG8_BAR;
    }
    for (;;) {
        const bool has_next = S.next(ui + 1, nxt);
        const char* nA = has_next ? (const char*)g.A + (size_t)nxt.pm * tstep : cA; const char* nB = has_next ? (const char*)g.Bt + (size_t)nxt.pn * tstep : cB;
        for (int t = 0; t < nt; t += 2) {
            const bool last = (t == nt - 2);
            const char* a1 = cA + (size_t)(t + 1) * kstep;
            const char* a2 = last ? nA : cA + (size_t)(t + 2) * kstep; const char* b2 = last ? nB : cB + (size_t)(t + 2) * kstep;
            const char* a3 = a2 + kstep; const char* b3 = b2 + kstep;
            if (last && has_next) S.a_ready(nxt);
            if constexpr (SP2) {
            PG8_LDB(B0, 0, 0); PG8_LDB(B1, 0, 1); PG8_SCHED; PG8_LDA(At, 0, 0); PG8_STAGE(PG8_SA(1, 1), a1 + hstep, voffA);
            PG8_WAIT_V(8); PG8_WAIT_L(0); PG8_BAR; PG8_MMA(0, 0, At, B0); PG8_MMA(0, 1, At, B1); PG8_BAR; PG8_SCHED;
            PG8_LDA(At, 0, 1); PG8_STAGE(PG8_SB(0, 0), b2, voffB); PG8_STAGE(PG8_SB(0, 1), b2 + hstep, voffB); PG8_STAGE(PG8_SA(0, 0), a2, voffA);
            PG8_WAIT_V(8); PG8_WAIT_L(0); PG8_BAR; PG8_MMA(1, 0, At, B0); PG8_MMA(1, 1, At, B1); PG8_BAR; PG8_SCHED;
            PG8_LDB(B0, 1, 0); PG8_LDB(B1, 1, 1); PG8_SCHED; PG8_LDA(At, 1, 0); PG8_STAGE(PG8_SA(0, 1), a2 + hstep, voffA);
            PG8_WAIT_V(8); PG8_WAIT_L(0); PG8_BAR; PG8_MMA(0, 0, At, B0); PG8_MMA(0, 1, At, B1); PG8_BAR; PG8_SCHED;
            PG8_LDA(At, 1, 1); PG8_STAGE(PG8_SB(1, 0), b3, voffB); PG8_STAGE(PG8_SB(1, 1), b3 + hstep, voffB); PG8_STAGE(PG8_SA(1, 0), a3, voffA);
            PG8_WAIT_V(8); PG8_WAIT_L(0); PG8_BAR; PG8_MMA(1, 0, At, B0); PG8_MMA(1, 1, At, B1); PG8_BAR; PG8_SCHED;
            } else {
            PG8_LDB(B0, 0, 0); PG8_SCHED; PG8_LDA(At, 0, 0); PG8_STAGE(PG8_SA(1, 1), a1 + hstep, voffA);
            PG8_WAIT_L(8); PG8_BAR; PG8_WAIT_L(0); PG8_MMA(0, 0, At, B0); PG8_BAR; PG8_SCHED;
            PG8_LDB(B1, 0, 1); PG8_STAGE(PG8_SB(0, 0), b2, voffB);
            PG8_BAR; PG8_WAIT_L(0); PG8_MMA(0, 1, At, B1); PG8_BAR;
            PG8_LDA(At, 0, 1); PG8_STAGE(PG8_SA(0, 0), a2, voffA);
            PG8_BAR; PG8_WAIT_L(0); PG8_MMA(1, 0, At, B0); PG8_BAR; PG8_SCHED;
            PG8_STAGE(PG8_SB(0, 1), b2 + hstep, voffB);
            PG8_WAIT_V(6); PG8_BAR; PG8_MMA(1, 1, At, B1); PG8_BAR;
            PG8_LDB(B0, 1, 0); PG8_SCHED; PG8_LDA(At, 1, 0); PG8_STAGE(PG8_SA(0, 1), a2 + hstep, voffA);
            PG8_WAIT_L(8); PG8_BAR; PG8_WAIT_L(0); PG8_MMA(0, 0, At, B0); PG8_BAR; PG8_SCHED;
            PG8_LDB(B1, 1, 1); PG8_STAGE(PG8_SB(1, 0), b3, voffB);
            PG8_BAR; PG8_WAIT_L(0); PG8_MMA(0, 1, At, B1); PG8_BAR;
            PG8_LDA(At, 1, 1); PG8_STAGE(PG8_SA(1, 0), a3, voffA);
            PG8_BAR; PG8_WAIT_L(0); PG8_MMA(1, 0, At, B0); PG8_BAR; PG8_SCHED;
            PG8_STAGE(PG8_SB(1, 1), b3 + hstep, voffB);
            PG8_WAIT_V(6); PG8_BAR; PG8_MMA(1, 1, At, B1); PG8_BAR;
            }
        }
        if constexpr (ALIGN_EPI) { if (wr == 0) PG8_BAR; }
        if constexpr (!Epi::AFTER_DRAIN) { E(acc, cur, wr, wc, fr, fq); S.done(cur); }
        if (!has_next) break;
#pragma unroll
        for (int a = 0; a < 2; ++a)
#pragma unroll
            for (int b = 0; b < 2; ++b)
#pragma unroll
                for (int m = 0; m < 4; ++m)
#pragma unroll
                    for (int n = 0; n < 2; ++n) acc[a][b][m][n] = (f32x4){0.f, 0.f, 0.f, 0.f};
        cur = nxt; cA = nA; cB = nB; ++ui;
        if constexpr (ALIGN_EPI) { if (wr == 1) PG8_BAR; }
    }
    PG8_WAIT_V(0);
    if constexpr (!ALIGN_EPI) { if (wr == 0) PG8_BAR; }
    PG8_BAR;
    if constexpr (Epi::AFTER_DRAIN) { E.fused(acc, cur, wr, wc, fr, fq, lds, wid, lane); S.done(cur); }
#undef PG8_SA
#undef PG8_SB
#undef PG8_STAGE
#undef PG8_LDA
#undef PG8_LDB
#undef PG8_MMA
#undef PG8_WAIT_V
#undef PG8_WAIT_L
#undef PG8_BAR
#undef PG8_SCHED
}
}

#define ST4(ptr, V, O) do { u32x2 w_ = {cvtpk(V[(O) + 0], V[(O) + 1]), cvtpk(V[(O) + 2], V[(O) + 3])}; *(u32x2*)(ptr) = w_; } while (0)
#define PG8_FOREACH(acc, u, F) do {                                                                                   \
    _Pragma("unroll") for (int ai = 0; ai < 2; ++ai) _Pragma("unroll") for (int bj = 0; bj < 2; ++bj) _Pragma("unroll") for (int m = 0; m < 4; ++m) {   \
      const int row_ = (u).pm * 256 + ai * 128 + wr * 64 + m * 16 + fr, c0_ = (u).pn * 256 + bj * 128 + wc * 32 + 8 * fq;   \
      F(acc[ai][bj][m][0], acc[ai][bj][m][1], row_, c0_); SBAR(); } } while (0)

struct EpiG3 {
  static constexpr bool PERM = true, AFTER_DRAIN = false;
  const float* x; float* out; const float* bo;
  __device__ __forceinline__ void blk(const f32x4& a0, const f32x4& a1, int row, int c0) const {
    const f32x4 b0 = *(const f32x4*)(bo + c0), b1 = *(const f32x4*)(bo + c0 + 4);
    const f32x4 x0 = *(const f32x4*)(x + (long)row * DM + c0), x1 = *(const f32x4*)(x + (long)row * DM + c0 + 4);
    *(f32x4*)(out + (long)row * DM + c0) = a0 + b0 + ALPHA * x0;
    *(f32x4*)(out + (long)row * DM + c0 + 4) = a1 + b1 + ALPHA * x1;
  }
  __device__ __forceinline__ void operator()(const f32x4 (&acc)[2][2][4][2], const pg8::Unit& u, int wr, int wc, int fr, int fq) const {
#define G3F(A0, A1, R, C) blk(A0, A1, R, C)
    PG8_FOREACH(acc, u, G3F);
#undef G3F
  }
};
__device__ __forceinline__ void phase_gemm3_new(const Params& p, int g, char* lds, int vid) {
  unsigned char* ws = p.ws;
  EpiG3 E; E.x = p.x[g]; E.out = p.out + (size_t)g * TG * DM; E.bo = p.b_out;
  pg8::Gemm G; G.A = (const bf16_t*)(ws + OFF_XB); G.Bt = (const bf16_t*)(ws + OFF_WOUT); G.M = TG; G.N = 1024; G.K = DM;
  pg8::GroupOrder S; S.xg = vid & 7; S.jl = vid >> 3; S.npn = 4;
  pg8::gemm_phase<EpiG3, pg8::GroupOrder, false, true>((PG8_LAS unsigned char*)lds, G, S, E);
}

struct EpiG1n {
  static constexpr bool PERM = true, AFTER_DRAIN = false;
  bf16_t *U, *CGb, *Qb, *Kb, *Vb, *AGb, *MCb, *MAb; const f32x2* rope; const float* biasv; int seqmask;
  template <int KIND> __device__ __forceinline__ void blk(const f32x4& a0, const f32x4& a1, int row, int c0) const {
    const f32x4 b0 = *(const f32x4*)(biasv + c0), b1 = *(const f32x4*)(biasv + c0 + 4);
    float v[8] = {a0[0] + b0[0], a0[1] + b0[1], a0[2] + b0[2], a0[3] + b0[3], a1[0] + b1[0], a1[1] + b1[1], a1[2] + b1[2], a1[3] + b1[3]};
    if constexpr (KIND == 0 || KIND == 2 || KIND == 3) {
      float w[8];
#pragma unroll
      for (int j = 0; j < 8; ++j) w[j] = __shfl_xor(v[j], 16);
      const int par = (c0 >> 3) & 1, cg = c0 & ~15;
      if constexpr (KIND == 0) {
        if (par == 0) { float o[8];
#pragma unroll
          for (int j = 0; j < 8; ++j) o[j] = v[j] * sigmoidf_(w[j]);
          ST8(U + (long)row * 512 + (cg >> 1), o, 0); }
      } else {
        constexpr bool isq = (KIND == 2); const int j0 = cg - (isq ? 1536 : 2048), b = j0 >> 5, gq = b >> 1, sub = b & 1, d0 = 16 * sub + 8 * ((j0 >> 4) & 1);
        const int pos = row & seqmask;
        const f32x2* cs = rope + (long)pos * 32 + d0;
        const f32x4 c01 = *(const f32x4*)cs, c23 = *(const f32x4*)(cs + 2), c45 = *(const f32x4*)(cs + 4), c67 = *(const f32x4*)(cs + 6);
        const float cc[8] = {c01[0], c01[2], c23[0], c23[2], c45[0], c45[2], c67[0], c67[2]}, sn[8] = {c01[1], c01[3], c23[1], c23[3], c45[1], c45[3], c67[1], c67[3]};
        float o[8]; constexpr float sc = isq ? QSCALE : 1.f; const float sg = par ? 1.f : -1.f;
#pragma unroll
        for (int j = 0; j < 8; ++j) o[j] = (v[j] * cc[j] + sg * (w[j] * sn[j])) * sc;
        ST8((isq ? Qb : Kb) + (long)row * 512 + 64 * gq + d0 + 32 * par, o, 0);
      }
    } else if constexpr (KIND == 1 || KIND == 5) {
      float o[8];
#pragma unroll
      for (int j = 0; j < 8; ++j) o[j] = siluf_(v[j]);
      bf16_t* dp = (KIND == 1) ? (CGb + (long)row * 512 + (c0 - 1024)) : (AGb + (long)row * 512 + (c0 - 3072)); ST8(dp, o, 0);
    } else if constexpr (KIND == 4) {
      ST8(Vb + (long)row * 512 + (c0 - 2560), v, 0);
    } else {
      float o[8];
#pragma unroll
      for (int j = 0; j < 8; ++j) o[j] = sigmoidf_(v[j]);
      bf16_t* dp = (KIND == 6) ? (MCb + (long)row * 1024 + (c0 - 3584)) : (MAb + (long)row * 1024 + (c0 - 4608)); ST8(dp, o, 0);
    }
  }
  template <int KIND> __device__ __forceinline__ void all(const f32x4 (&acc)[2][2][4][2], const pg8::Unit& u, int wr, int wc, int fr, int fq) const {
#define G1F(A0, A1, R, C) blk<KIND>(A0, A1, R, C)
    PG8_FOREACH(acc, u, G1F);
#undef G1F
  }
  __device__ __forceinline__ void operator()(const f32x4 (&acc)[2][2][4][2], const pg8::Unit& u, int wr, int wc, int fr, int fq) const {
    const int pn = u.pn;
    if (pn < 4) all<0>(acc, u, wr, wc, fr, fq);
    else if (pn < 6) all<1>(acc, u, wr, wc, fr, fq);
    else if (pn < 8) all<2>(acc, u, wr, wc, fr, fq);
    else if (pn < 10) all<3>(acc, u, wr, wc, fr, fq);
    else if (pn < 12) all<4>(acc, u, wr, wc, fr, fq);
    else if (pn < 14) all<5>(acc, u, wr, wc, fr, fq);
    else if (pn < 18) all<6>(acc, u, wr, wc, fr, fq);
    else all<7>(acc, u, wr, wc, fr, fq);
  }
};
__device__ __forceinline__ void phase_gemm1_new(const Params& p, int g, char* lds, int vid) {
  unsigned char* ws = p.ws;
  EpiG1n E;
  E.biasv = (const float*)(ws + OFF_BIASV); E.rope = (const f32x2*)(ws + OFF_ROPE);
  E.U = (bf16_t*)(ws + OFF_U); E.CGb = (bf16_t*)(ws + OFF_CG); E.Qb = (bf16_t*)(ws + OFF_Q); E.Kb = (bf16_t*)(ws + OFF_K);
  E.Vb = (bf16_t*)(ws + OFF_V); E.AGb = (bf16_t*)(ws + OFF_AG); E.MCb = (bf16_t*)(ws + OFF_MC); E.MAb = (bf16_t*)(ws + OFF_MA);
  E.seqmask = (g == 0) ? 16383 : 8191;
  pg8::Gemm G; G.A = (g == 0) ? (const bf16_t*)(ws + OFF_XB) : (const bf16_t*)((unsigned char*)p.out + (size_t)TG * DM * 4); G.Bt = (const bf16_t*)(ws + OFF_WIN); G.M = TG; G.N = NV; G.K = DM;
  pg8::GroupOrder S; S.xg = vid & 7; S.jl = vid >> 3; S.npn = 20;
  pg8::gemm_phase<EpiG1n, pg8::GroupOrder, true, true>((PG8_LAS unsigned char*)lds, G, S, E);
  {
    const int tid = otid(), wid = tid >> 6, lane = tid & 63, wr = wid >> 2, wc = wid & 3, r32 = lane & 31, hi = lane >> 5;
    const int xg = vid & 7, jl = vid >> 3;
    G1Ptrs P; P.biasv = E.biasv; P.rope = E.rope; P.U = E.U; P.CGb = E.CGb; P.Qb = E.Qb; P.Kb = E.Kb; P.Vb = E.Vb; P.AGb = E.AGb; P.MCb = E.MCb; P.MAb = E.MAb; P.seqmask = E.seqmask;
    int pm = 8 * xg + (jl & 7); const int n0 = 20 * 256 + 128 * (jl >> 3);
    asm volatile("" : "+s"(pm));
    f32x16 acc1[4][1];
#pragma unroll
    for (int mi = 0; mi < 4; ++mi) acc1[mi][0] = f32x16{};
    gemm_loop<1>(G.A + (long)pm * 256 * DM, DM, G.Bt + (long)n0 * DM, DM, DM / 64, lds, acc1);
    const int row0 = pm * 256 + 128 * wr + r32, vc0 = n0 + 32 * wc + 16 * hi;
    g1_block<7>(acc1[0][0], P, row0, vc0, hi); SBAR();
    g1_block<7>(acc1[1][0], P, row0 + 32, vc0, hi); SBAR();
    g1_block<7>(acc1[2][0], P, row0 + 64, vc0, hi); SBAR();
    g1_block<7>(acc1[3][0], P, row0 + 96, vc0, hi); SBAR();
  }
}

__device__ __forceinline__ void phase_ln(const Params& p, int g) {
  float* out = p.out + (size_t)g * TG * DM;
  const int tid = otid(), wid = tid >> 6, lane = tid & 63;
  for (int row = blockIdx.x * 8 + wid; row < TG; row += gridDim.x * 8) {
    float* rp = out + (long)row * DM;
    f32x4 v[4]; float s = 0.f;
#pragma unroll
    for (int i = 0; i < 4; ++i) { v[i] = *(const f32x4*)(rp + i * 256 + lane * 4); s += (v[i][0] + v[i][1]) + (v[i][2] + v[i][3]); }
#pragma unroll
    for (int m = 1; m < 64; m <<= 1) s += __shfl_xor(s, m);
    const float mean = s * (1.f / 1024.f); float q = 0.f;
#pragma unroll
    for (int i = 0; i < 4; ++i) { v[i] = v[i] - mean; q += (v[i][0] * v[i][0] + v[i][1] * v[i][1]) + (v[i][2] * v[i][2] + v[i][3] * v[i][3]); }
#pragma unroll
    for (int m = 1; m < 64; m <<= 1) q += __shfl_xor(q, m);
    const float rstd = rsqrtf(q * (1.f / 1024.f) + LN_EPS);
#pragma unroll
    for (int i = 0; i < 4; ++i) { f32x4 gg = *(const f32x4*)(p.ln_g + i * 256 + lane * 4), bb = *(const f32x4*)(p.ln_b + i * 256 + lane * 4);
      *(f32x4*)(rp + i * 256 + lane * 4) = v[i] * rstd * gg + bb; }
  }
}

__device__ __forceinline__ void phase_prologue(const Params& p, char* lds) {
  unsigned char* ws = p.ws;
  int bi = 0;
  for (int t = blockIdx.x; t < 1920; t += gridDim.x, ++bi) {
    if (t < 1408) transpose_tile(p, bi, p.w_in, NV, 1024, (bf16_t*)(ws + OFF_WIN), true, t >> 4, t & 15, lds);
    else if (t < 1536) transpose_tile(p, bi, p.w_cp, 1024, 512, (bf16_t*)(ws + OFF_WCP), false, (t - 1408) >> 3, (t - 1408) & 7, lds);
    else if (t < 1664) transpose_tile(p, bi, p.w_ao, 1024, 512, (bf16_t*)(ws + OFF_WAO), false, (t - 1536) >> 3, (t - 1536) & 7, lds);
    else transpose_tile(p, bi, p.w_out, 1024, 1024, (bf16_t*)(ws + OFF_WOUT), false, (t - 1664) >> 4, (t - 1664) & 15, lds);
  }
  for (; bi < 8; ++bi) cvt_batch(p, bi);
  const long gt = (long)blockIdx.x * NTHR + threadIdx.x, gn = (long)gridDim.x * NTHR;
  float* biasv = (float*)(ws + OFF_BIASV);
  for (long i = gt; i < NV; i += gn) biasv[i] = p.b_in[win_actual((int)i)];
  f32x2* rope = (f32x2*)(ws + OFF_ROPE);
  for (long i = gt; i < 16384L * 32; i += gn) { const int pos = (int)(i >> 5), f = (int)(i & 31); const double a = (double)pos * p.inv_freq_pi[f];
    rope[i] = f32x2{(float)cospi(a), (float)sinpi(a)}; }
  if (gt == 0) { float s1 = 0.f, s2 = 0.f; for (int i = 0; i < 64; ++i) { s1 += p.lq1[i] * p.lk1[i]; s2 += p.lq2[i] * p.lk2[i]; }
    *(float*)(ws + OFF_MISC) = expf(s1) - expf(s2) + LAM_INIT; }
}

__device__ __forceinline__ void panel_arrive(unsigned* cnt) {
  asm volatile("s_waitcnt vmcnt(0) lgkmcnt(0)" ::: "memory"); __syncthreads();
  if (threadIdx.x == 0) { __builtin_amdgcn_fence(__ATOMIC_RELEASE, "agent"); asm volatile("s_waitcnt vmcnt(0)" ::: "memory");
    __hip_atomic_fetch_add(cnt, 1u, __ATOMIC_RELAXED, __HIP_MEMORY_SCOPE_AGENT); }
}
__device__ __forceinline__ void panel_wait(unsigned* cnt, unsigned want) {
  if (threadIdx.x == 0) { while (__hip_atomic_load(cnt, __ATOMIC_RELAXED, __HIP_MEMORY_SCOPE_AGENT) < want) __builtin_amdgcn_s_sleep(1);
    __builtin_amdgcn_fence(__ATOMIC_ACQUIRE, "agent"); asm volatile("s_waitcnt vmcnt(0)" ::: "memory"); }
  __syncthreads();
}
__device__ __forceinline__ void phase_ln_panel(const Params& p, int g, int vid) {
  float* out = p.out + (size_t)g * TG * DM;
  const int tid = otid(), wid = tid >> 6, lane = tid & 63;
  const int xg = vid & 7, jl = vid >> 3, row0 = (8 * xg + (jl & 7)) * 256 + (jl >> 3) * 64 + wid * 8;
#pragma unroll 1
  for (int i = 0; i < 8; ++i) {
    float* rp = out + (long)(row0 + i) * DM;
    f32x4 v[4]; float sm = 0.f;
#pragma unroll
    for (int k = 0; k < 4; ++k) { v[k] = *(const f32x4*)(rp + k * 256 + lane * 4); sm += (v[k][0] + v[k][1]) + (v[k][2] + v[k][3]); }
#pragma unroll
    for (int m = 1; m < 64; m <<= 1) sm += __shfl_xor(sm, m);
    const float mean = sm * (1.f / 1024.f); float q = 0.f;
#pragma unroll
    for (int k = 0; k < 4; ++k) { v[k] = v[k] - mean; q += (v[k][0] * v[k][0] + v[k][1] * v[k][1]) + (v[k][2] * v[k][2] + v[k][3] * v[k][3]); }
#pragma unroll
    for (int m = 1; m < 64; m <<= 1) q += __shfl_xor(q, m);
    const float rstd = rsqrtf(q * (1.f / 1024.f) + LN_EPS);
#pragma unroll
    for (int k = 0; k < 4; ++k) { f32x4 gg = *(const f32x4*)(p.ln_g + k * 256 + lane * 4), bb = *(const f32x4*)(p.ln_b + k * 256 + lane * 4);
      *(f32x4*)(rp + k * 256 + lane * 4) = v[k] * rstd * gg + bb; }
  }
}

#define LAS __attribute__((address_space(3)))
#define XB_TMO      128
#define XB_XCNT(j)  (256  + 64 * (j))
#define XB_XSUB(j)  (1280 + 64 * (j))
#define XB_XGEN(j)  (2304 + 64 * (j))
#define XB_TOP      3328
#define XB_TOPGEN   3392
#define XCD_BAR_WORDS 3456
#define XB_SPIN_CAP (1u << 18)

__device__ __forceinline__ unsigned xb_ld(unsigned* p)              { return __hip_atomic_load(p, __ATOMIC_RELAXED, __HIP_MEMORY_SCOPE_AGENT); }
__device__ __forceinline__ unsigned xb_add(unsigned* p, unsigned v) { return __hip_atomic_fetch_add(p, v, __ATOMIC_RELAXED, __HIP_MEMORY_SCOPE_AGENT); }
__device__ __forceinline__ unsigned xb_xcc_id() { return (unsigned)__builtin_amdgcn_s_getreg((3 << 11) | 20) & 0xFu; }
#define XB_SPIN(cond, bar) do { unsigned _sp = 0; while (cond) { __builtin_amdgcn_s_sleep(1); \
    if ((++_sp & 255u) == 0u) { if (xb_ld(&(bar)[XB_TMO])) break; if (_sp > XB_SPIN_CAP) { atomicAdd(&(bar)[XB_TMO], 1u); break; } } } } while (0)

struct XcdBarrier {
    unsigned* bar; unsigned x;
    volatile LAS unsigned* st;
};

__device__ __forceinline__ XcdBarrier xcd_barrier_post(unsigned* bar, volatile LAS unsigned* st) {
    XcdBarrier b; b.bar = bar; b.x = xb_xcc_id(); b.st = st;
    if (threadIdx.x == 0) (void)xb_add(&bar[XB_XCNT(b.x)], 1u);
    return b;
}
__device__ __forceinline__ void xcd_barrier_complete(unsigned* bar, unsigned x, unsigned& nloc, unsigned& nx) {
    const unsigned G = gridDim.x * gridDim.y * gridDim.z;
    unsigned sum, cnt, mine, sp = 0u;
    for (;;) {
        sum = 0u; cnt = 0u; mine = 0u;
#pragma unroll
        for (unsigned j = 0; j < 16; ++j) { const unsigned c = xb_ld(&bar[XB_XCNT(j)]); sum += c; cnt += (c > 0u) ? 1u : 0u; mine = (j == x) ? c : mine; }
        if (sum == G) break;
        __builtin_amdgcn_s_sleep(1);
        if ((++sp & 255u) == 0u) { if (xb_ld(&bar[XB_TMO])) break; if (sp > XB_SPIN_CAP) { atomicAdd(&bar[XB_TMO], 1u); break; } }
    }
    nloc = mine > 0u ? mine : 1u; nx = cnt > 0u ? cnt : 1u;
}

__device__ __forceinline__ void xcd_barrier(const XcdBarrier& b) {
    asm volatile("s_waitcnt vmcnt(0)" ::: "memory");
    __syncthreads();
    if (threadIdx.x == 0) {
        unsigned* bar = b.bar;
        __builtin_amdgcn_s_waitcnt(0);
        unsigned nloc = b.st[0], nx = b.st[1];
        if (nloc == 0u) { xcd_barrier_complete(bar, b.x, nloc, nx); b.st[0] = nloc; b.st[1] = nx; }
        const unsigned old = xb_add(&bar[XB_XSUB(b.x)], 1u);
        const unsigned gen = old / nloc;
        if (old + 1u == (gen + 1u) * nloc) {
            __builtin_amdgcn_fence(__ATOMIC_RELEASE, "agent");
            asm volatile("s_waitcnt vmcnt(0)" ::: "memory");
            const unsigned og = xb_add(&bar[XB_TOP], 1u);
            const unsigned tg = og / nx;
            if (og + 1u == (tg + 1u) * nx) xb_add(&bar[XB_TOPGEN], 1u);
            else XB_SPIN(xb_ld(&bar[XB_TOPGEN]) == tg, bar);
            __builtin_amdgcn_fence(__ATOMIC_ACQUIRE, "agent");
            xb_add(&bar[XB_XGEN(b.x)], 1u);
            asm volatile("s_waitcnt vmcnt(0)" ::: "memory");
        } else {
            XB_SPIN(xb_ld(&bar[XB_XGEN(b.x)]) == gen, bar);
            __builtin_amdgcn_fence(__ATOMIC_ACQUIRE, "agent");
            asm volatile("s_waitcnt vmcnt(0)" ::: "memory");
        }
    }
    __syncthreads();
}

__global__ void __launch_bounds__(NTHR, 2) fwd_kernel(Params p) {
  extern __shared__ __attribute__((aligned(16))) char lds[];
#if MULTI_LAUNCH
#define GSYNC() do { } while (0)
#else
  cg::grid_group grid = cg::this_grid();
  unsigned* bar = (unsigned*)(p.ws + OFF_BAR);
  volatile LAS unsigned* xst = (volatile LAS unsigned*)(lds + LDS_BYTES - 32);
  if (threadIdx.x == 0) { xst[0] = 0u; xst[1] = 0u; }
  __syncthreads();
  const XcdBarrier xb = xcd_barrier_post((unsigned*)(p.ws + OFF_XBAR), xst);
#define GSYNC() xcd_barrier(xb)
#endif
  int vid = blockIdx.x;
#if !MULTI_LAUNCH
  unsigned my_xcc = 0, my_rank = 0;
  if (threadIdx.x == 0) { my_xcc = (unsigned)__builtin_amdgcn_s_getreg((3 << 11) | 20) & 7u; my_rank = __hip_atomic_fetch_add(bar + 8 + my_xcc, 1u, __ATOMIC_RELAXED, __HIP_MEMORY_SCOPE_AGENT); }
#endif
  int ph = 0;
#define PHASE(body) do { if (ph >= p.ph_lo && ph < p.ph_hi) { body; if (ph + 1 < p.ph_hi) GSYNC(); } ++ph; } while (0)
  PHASE(phase_prologue(p, lds));
#if !MULTI_LAUNCH
  {
    int* vsh = (int*)(lds + LDS_BYTES - 16);
    if (threadIdx.x == 0) { bool ok = true; for (int i = 0; i < 8; ++i) ok = ok && (__hip_atomic_load(bar + 8 + i, __ATOMIC_RELAXED, __HIP_MEMORY_SCOPE_AGENT) == 32u);
      *vsh = (ok && my_rank < 32u) ? (int)(my_xcc + 8u * my_rank) : (int)blockIdx.x; }
    __syncthreads(); vid = __builtin_amdgcn_readfirstlane(*vsh); __syncthreads();
  }
#endif
  for (int g = 0; g < 2; ++g) {
    PHASE(phase_gemm1_new(p, g, lds, vid));
    PHASE({ phase_conv(p, g, lds); phase_attn(p, g, lds, vid); });
    PHASE({ unsigned* pw = (unsigned*)(p.ws + OFF_BAR); const int pm_ = 8 * (vid & 7) + ((vid >> 3) & 7);
            phase_gemm2(p, lds, vid); panel_arrive(pw + 64 + 64 * g + pm_); panel_wait(pw + 64 + 64 * g + pm_, 4u);
            phase_gemm3_new(p, g, lds, vid); panel_arrive(pw + 192 + 64 * g + pm_); panel_wait(pw + 192 + 64 * g + pm_, 4u);
            phase_ln_panel(p, g, vid); });
  }
}
constexpr int N_PHASES = 7;

extern "C" void kernel_launch(void* const* d_in, const int* in_sizes, int n_in, void* d_out, int out_size, void* d_ws, size_t ws_size, hipStream_t stream) {
  static int grid = 0;
  if (grid == 0) {
    if (n_in != 20 || ws_size < WS_END || out_size != 2 * TG * DM) { fprintf(stderr, "kernel_launch: unexpected shapes n_in %d ws %zu out %d\n", n_in, ws_size, out_size); grid = -1; return; }
    int dev = 0, cus = 0, per_cu = 0;
    hipGetDevice(&dev); hipDeviceGetAttribute(&cus, hipDeviceAttributeMultiprocessorCount, dev);
    if (hipFuncSetAttribute((const void*)fwd_kernel, hipFuncAttributeMaxDynamicSharedMemorySize, LDS_BYTES) != hipSuccess) { fprintf(stderr, "kernel_launch: LDS attribute failed\n"); grid = -1; return; }
    hipOccupancyMaxActiveBlocksPerMultiprocessor(&per_cu, (const void*)fwd_kernel, NTHR, LDS_BYTES);
    if (per_cu < 1) { fprintf(stderr, "kernel_launch: occupancy query says %d\n", per_cu); per_cu = 1; }
    grid = cus;
    if (grid != 256) { fprintf(stderr, "kernel_launch: built for 256 CUs, found %d\n", grid); grid = 256; }
  }
  if (grid < 0) return;
  Params p{};
  p.x[0] = (const float*)d_in[0]; p.x[1] = (const float*)d_in[1];
  p.w_in = (const float*)d_in[2]; p.b_in = (const float*)d_in[3]; p.conv_dw = (const float*)d_in[4]; p.conv_dw_b = (const float*)d_in[5];
  p.conv_ln_g = (const float*)d_in[6]; p.conv_ln_b = (const float*)d_in[7]; p.w_cp = (const float*)d_in[8]; p.b_cp = (const float*)d_in[9];
  p.lq1 = (const float*)d_in[10]; p.lk1 = (const float*)d_in[11]; p.lq2 = (const float*)d_in[12]; p.lk2 = (const float*)d_in[13];
  p.subln_g = (const float*)d_in[14]; p.w_ao = (const float*)d_in[15]; p.w_out = (const float*)d_in[16]; p.b_out = (const float*)d_in[17];
  p.ln_g = (const float*)d_in[18]; p.ln_b = (const float*)d_in[19];
  p.out = (float*)d_out; p.ws = (unsigned char*)d_ws;
  for (int i = 0; i < 32; ++i) p.inv_freq_pi[i] = pow(10000.0, -(double)i / 32.0) / 3.14159265358979323846;
#if MULTI_LAUNCH
  for (int ph = 0; ph < N_PHASES; ++ph) { p.ph_lo = ph; p.ph_hi = ph + 1; hipLaunchKernelGGL(fwd_kernel, dim3(grid), dim3(NTHR), LDS_BYTES, stream, p); }
#else
  p.ph_lo = 0; p.ph_hi = N_PHASES;
  if (hipMemsetAsync((unsigned char*)d_ws + OFF_BAR, 0, 4096 + 16384, stream) != hipSuccess) { fprintf(stderr, "kernel_launch: memset failed\n"); return; }
  void* args[] = {&p};
  hipError_t e = hipLaunchCooperativeKernel((const void*)fwd_kernel, dim3(grid), dim3(NTHR), args, LDS_BYTES, stream);
  if (e != hipSuccess) fprintf(stderr, "kernel_launch: cooperative launch failed: %s\n", hipGetErrorString(e));
#endif
}
```

```cpp
#include <hip/hip_runtime.h>
#include <hip/hip_cooperative_groups.h>
#include <cstdint>
#include <cstdio>
#include <cmath>
namespace cg = cooperative_groups;

#ifndef MULTI_LAUNCH
#define MULTI_LAUNCH 0
#endif

typedef unsigned short bf16_t;
typedef short bf16x8 __attribute__((ext_vector_type(8)));
typedef short s16x4 __attribute__((ext_vector_type(4)));
typedef float f32x16 __attribute__((ext_vector_type(16)));
typedef float f32x4 __attribute__((ext_vector_type(4)));
typedef float f32x2 __attribute__((ext_vector_type(2)));
typedef unsigned u32x4 __attribute__((ext_vector_type(4)));
typedef unsigned u32x2 __attribute__((ext_vector_type(2)));

constexpr int DM = 1024, TG = 16384, NV = 5632, NTHR = 512;
constexpr float LN_EPS = 1e-5f;
constexpr float ALPHA = 1.189207115002721f;
constexpr float LAM_INIT = 0.2f;
constexpr float QSCALE = 0.125f * 1.4426950408889634f;

constexpr size_t OFF_WIN = 0;
constexpr size_t OFF_WCP = OFF_WIN + (size_t)NV * 1024 * 2;
constexpr size_t OFF_WAO = OFF_WCP + (size_t)1024 * 512 * 2;
constexpr size_t OFF_WOUT = OFF_WAO + (size_t)1024 * 512 * 2;
constexpr size_t OFF_BIASV = OFF_WOUT + (size_t)1024 * 1024 * 2;
constexpr size_t OFF_ROPE = OFF_BIASV + 32768;
constexpr size_t OFF_MISC = OFF_ROPE + (size_t)16384 * 32 * 8;
constexpr size_t OFF_XB = OFF_MISC + 256;
constexpr size_t OFF_U = OFF_XB + (size_t)TG * 1024 * 2;
constexpr size_t OFF_CG = OFF_U + (size_t)TG * 512 * 2;
constexpr size_t OFF_Q = OFF_CG + (size_t)TG * 512 * 2;
constexpr size_t OFF_K = OFF_Q + (size_t)TG * 512 * 2;
constexpr size_t OFF_V = OFF_K + (size_t)TG * 512 * 2;
constexpr size_t OFF_AG = OFF_V + (size_t)TG * 512 * 2;
constexpr size_t OFF_MC = OFF_AG + (size_t)TG * 512 * 2;
constexpr size_t OFF_MA = OFF_MC + (size_t)TG * 1024 * 2;
constexpr size_t OFF_U2 = OFF_MA + (size_t)TG * 1024 * 2;
constexpr size_t OFF_O2 = OFF_U2 + (size_t)TG * 512 * 2;
constexpr size_t OFF_BAR = OFF_O2 + (size_t)TG * 512 * 2;
constexpr size_t OFF_XBAR = OFF_BAR + 4096;
constexpr size_t WS_END = OFF_XBAR + 16384;
static_assert(WS_END <= (size_t)256 * 1024 * 1024, "workspace over 256 MiB");
constexpr int LDS_BYTES = 131072 + 4096;

struct Params {
  const float* x[2];
  const float *w_in, *b_in, *conv_dw, *conv_dw_b, *conv_ln_g, *conv_ln_b, *w_cp, *b_cp, *lq1, *lk1, *lq2, *lk2, *subln_g, *w_ao, *w_out, *b_out, *ln_g, *ln_b;
  float* out;
  unsigned char* ws;
  double inv_freq_pi[32];
  int ph_lo, ph_hi;
};

__device__ __forceinline__ unsigned cvtpk(float lo, float hi) {
  unsigned r; asm volatile("v_cvt_pk_bf16_f32 %0, %1, %2" : "=v"(r) : "v"(lo), "v"(hi)); return r;
}
__device__ __forceinline__ float bf2f(unsigned short b) { return __uint_as_float(((unsigned)b) << 16); }
__device__ __forceinline__ float bflo(unsigned w) { return __uint_as_float(w << 16); }
__device__ __forceinline__ float bfhi(unsigned w) { return __uint_as_float(w & 0xffff0000u); }
__device__ __forceinline__ float sigmoidf_(float x) { return __builtin_amdgcn_rcpf(1.f + __expf(-x)); }
__device__ __forceinline__ float siluf_(float x) { return x * sigmoidf_(x); }
__device__ __forceinline__ int crow(int r, int hi) { return (r & 3) + 8 * (r >> 2) + 4 * hi; }
#define SBAR() __builtin_amdgcn_sched_barrier(0)
__device__ __forceinline__ int otid() { int t = threadIdx.x; asm volatile("" : "+v"(t)); return t; }

__device__ __forceinline__ int win_actual(int v) {
  if (v < 1024) { int b = v >> 5, h = (v >> 4) & 1, r = v & 15; int ch = 16 * b + 8 * h + (r & 7); return (r < 8) ? ch : 512 + ch; }
  if (v < 1536) return v;
  if (v < 2560) { int base = (v < 2048) ? 1536 : 2048; int j = v - base; int b = j >> 5, h = (j >> 4) & 1, r = j & 15; int g = b >> 1, sub = b & 1;
    int d = 16 * sub + 8 * h + (r & 7); return base + 64 * g + d + ((r >= 8) ? 32 : 0); }
  return v;
}

__device__ __forceinline__ void cvt_batch(const Params& p, int bi) {
  const float* __restrict__ src = p.x[bi >> 2];
  bf16_t* __restrict__ dst = (bi < 4) ? (bf16_t*)(p.ws + OFF_XB) : (bf16_t*)((unsigned char*)p.out + (size_t)TG * DM * 4);
  const long gn = (long)gridDim.x * NTHR, i = (long)blockIdx.x * NTHR + threadIdx.x + (long)(bi & 3) * 4 * gn;
  f32x4 a[4], b[4];
#pragma unroll
  for (int u = 0; u < 4; ++u) { a[u] = __builtin_nontemporal_load((const f32x4*)(src + (i + u * gn) * 8)); b[u] = __builtin_nontemporal_load((const f32x4*)(src + (i + u * gn) * 8 + 4)); }
#pragma unroll
  for (int u = 0; u < 4; ++u) { u32x4 w = {cvtpk(a[u][0], a[u][1]), cvtpk(a[u][2], a[u][3]), cvtpk(b[u][0], b[u][1]), cvtpk(b[u][2], b[u][3])};
    *(u32x4*)(dst + (i + u * gn) * 8) = w; }
}
__device__ __forceinline__ void transpose_tile(const Params& p, int bi, const float* __restrict__ src, int NS, int K, bf16_t* __restrict__ dst, bool mapped, int vt, int kt, char* lds) {
  float* tl = (float*)lds;
  const int tid = threadIdx.x;
  float r[8];
  const int j = tid & 63, v = vt * 64 + j, col = mapped ? win_actual(v) : v;
#pragma unroll
  for (int i = 0; i < 8; ++i) { const int kk = (tid >> 6) + 8 * i; r[i] = src[(long)(kt * 64 + kk) * NS + col]; }
  cvt_batch(p, bi);
  __syncthreads();
#pragma unroll
  for (int i = 0; i < 8; ++i) { const int kk = (tid >> 6) + 8 * i; tl[j * 65 + kk] = r[i]; }
  __syncthreads();
  { const int jj = tid >> 3, kc = (tid & 7) * 8; const float* q = tl + jj * 65 + kc;
    u32x4 w = {cvtpk(q[0], q[1]), cvtpk(q[2], q[3]), cvtpk(q[4], q[5]), cvtpk(q[6], q[7])};
    *(u32x4*)(dst + (long)(vt * 64 + jj) * K + kt * 64 + kc) = w; }
}

__device__ __forceinline__ int vperm(int p) { return 16 * ((p >> 2) & 1) + (p & 3) + 4 * (p >> 3); }
template <int NI>
__device__ __forceinline__ void gemm_loop(const bf16_t* __restrict__ A, int lda, const bf16_t* __restrict__ B, int ldb, int KT, char* lds, f32x16 (&acc)[4][NI]) {
  constexpr int A_BYTES = 256 * 128, B_BYTES = 128 * NI * 128, STAGE = A_BYTES + B_BYTES;
  const int tid = otid(), wid = tid >> 6, lane = tid & 63, wr = wid >> 2, wc = wid & 3, r32 = lane & 31, hi = lane >> 5;
  const int wbase_ = __builtin_amdgcn_readfirstlane(wid) * 64;
  const bf16_t* ga[4]; const bf16_t* gb[2 * NI];
#pragma unroll
  for (int i = 0; i < 4; ++i) { int q = i * NTHR + tid, R = q >> 3, pc = q & 7, c = pc ^ ((R >> 1) & 7); ga[i] = A + (long)R * lda + c * 8; }
#pragma unroll
  for (int i = 0; i < 2 * NI; ++i) { int q = i * NTHR + tid, R = q >> 3, pc = q & 7, c = pc ^ ((R >> 1) & 7); int Rg = (R & ~31) + vperm(R & 31); gb[i] = B + (long)Rg * ldb + c * 8; }
  const int sw = (r32 >> 1) & 7;
  int xo[4];
#pragma unroll
  for (int ks = 0; ks < 4; ++ks) xo[ks] = r32 * 128 + (((2 * ks + hi) ^ sw) << 4);
  const int a_base = (128 * wr) * 128, b_base = A_BYTES + (32 * NI * wc) * 128;
#define GL_A(sb_, i, kt) __builtin_amdgcn_global_load_lds((const unsigned*)(ga[i] + (kt) * 64), (unsigned*)((sb_) + ((i) * NTHR + wbase_) * 16), 16, 0, 0)
#define GL_B(sb_, i, kt) __builtin_amdgcn_global_load_lds((const unsigned*)(gb[i] + (kt) * 64), (unsigned*)((sb_) + A_BYTES + ((i) * NTHR + wbase_) * 16), 16, 0, 0)
  {
#pragma unroll
    for (int i = 0; i < 4; ++i) GL_A(lds, i, 0);
#pragma unroll
    for (int i = 0; i < 2 * NI; ++i) GL_B(lds, i, 0);
  }
#pragma unroll 1
  for (int kt = 0; kt < KT; ++kt) {
    asm volatile("s_waitcnt vmcnt(0)" ::: "memory");
    __syncthreads();
    const bool more = kt + 1 < KT;
    char* sn = lds + ((kt + 1) & 1) * STAGE;
    const char* sb = lds + (kt & 1) * STAGE;
    bf16x8 af[2][4], bfr[2][NI];
#define FRAG_RD(S, ks) do { _Pragma("unroll") for (int ni = 0; ni < NI; ++ni) bfr[S][ni] = *(const bf16x8*)(sb + b_base + ni * 4096 + xo[ks]);   \
                            _Pragma("unroll") for (int mi = 0; mi < 4; ++mi) af[S][mi] = *(const bf16x8*)(sb + a_base + mi * 4096 + xo[ks]); } while (0)
    FRAG_RD(0, 0);
#pragma unroll
    for (int ks = 0; ks < 4; ++ks) {
      const int cs = ks & 1;
      if (ks < 3) { if (cs == 0) FRAG_RD(1, ks + 1); else FRAG_RD(0, ks + 1); }
      SBAR();
#pragma unroll
      for (int mi = 0; mi < 2; ++mi)
#pragma unroll
        for (int ni = 0; ni < NI; ++ni) acc[mi][ni] = __builtin_amdgcn_mfma_f32_32x32x16_bf16(bfr[cs][ni], af[cs][mi], acc[mi][ni], 0, 0, 0);
      SBAR();
      if (more) { GL_A(sn, ks, kt + 1); if (NI == 2) { GL_B(sn, ks, kt + 1); } else if (ks < 2) { GL_B(sn, ks, kt + 1); } }
      SBAR();
#pragma unroll
      for (int mi = 2; mi < 4; ++mi)
#pragma unroll
        for (int ni = 0; ni < NI; ++ni) acc[mi][ni] = __builtin_amdgcn_mfma_f32_32x32x16_bf16(bfr[cs][ni], af[cs][mi], acc[mi][ni], 0, 0, 0);
    }
#undef FRAG_RD
  }
#undef GL_A
#undef GL_B
}

#define ST8(ptr, V, O) do { u32x4 w_ = {cvtpk(V[(O) + 0], V[(O) + 1]), cvtpk(V[(O) + 2], V[(O) + 3]), cvtpk(V[(O) + 4], V[(O) + 5]), cvtpk(V[(O) + 6], V[(O) + 7])}; *(u32x4*)(ptr) = w_; } while (0)

struct G1Ptrs { bf16_t *U, *CGb, *Qb, *Kb, *Vb, *AGb, *MCb, *MAb; const f32x2* rope; const float* biasv; int seqmask; };
template <int KIND>
__device__ __forceinline__ void g1_block(const f32x16& a, const G1Ptrs& P, int row, int vc0, int hi) {
  float v[16];
#pragma unroll
  for (int j = 0; j < 4; ++j) { f32x4 b4 = *(const f32x4*)(P.biasv + vc0 + 4 * j); v[4 * j] = a[4 * j] + b4[0]; v[4 * j + 1] = a[4 * j + 1] + b4[1]; v[4 * j + 2] = a[4 * j + 2] + b4[2]; v[4 * j + 3] = a[4 * j + 3] + b4[3]; }
  if constexpr (KIND == 0) {
    float o[8];
#pragma unroll
    for (int j = 0; j < 8; ++j) o[j] = v[j] * sigmoidf_(v[8 + j]);
    ST8(P.U + (long)row * 512 + (vc0 >> 1), o, 0);
  } else if constexpr (KIND == 1 || KIND == 5) {
    float o[16];
#pragma unroll
    for (int j = 0; j < 16; ++j) o[j] = siluf_(v[j]);
    bf16_t* d = (KIND == 1) ? (P.CGb + (long)row * 512 + (vc0 - 1024)) : (P.AGb + (long)row * 512 + (vc0 - 3072)); ST8(d, o, 0); ST8(d + 8, o, 8);
  } else if constexpr (KIND == 2 || KIND == 3) {
    constexpr bool isq = (KIND == 2); const int j0 = vc0 - (isq ? 1536 : 2048);
    const int b = j0 >> 5, gq = b >> 1, sub = b & 1, d0 = 16 * sub + 8 * hi;
    const int pos = row & P.seqmask;
    const f32x2* cs = P.rope + (long)pos * 32 + d0;
    float o1[8], o2[8]; constexpr float sc = isq ? QSCALE : 1.f;
#pragma unroll
    for (int j = 0; j < 4; ++j) { f32x4 c2 = *(const f32x4*)(cs + 2 * j);
      o1[2 * j] = (v[2 * j] * c2[0] - v[8 + 2 * j] * c2[1]) * sc; o2[2 * j] = (v[8 + 2 * j] * c2[0] + v[2 * j] * c2[1]) * sc;
      o1[2 * j + 1] = (v[2 * j + 1] * c2[2] - v[9 + 2 * j] * c2[3]) * sc; o2[2 * j + 1] = (v[9 + 2 * j] * c2[2] + v[2 * j + 1] * c2[3]) * sc; }
    bf16_t* d = (isq ? P.Qb : P.Kb) + (long)row * 512 + 64 * gq + d0; ST8(d, o1, 0); ST8(d + 32, o2, 0);
  } else if constexpr (KIND == 4) {
    bf16_t* d = P.Vb + (long)row * 512 + (vc0 - 2560); ST8(d, v, 0); ST8(d + 8, v, 8);
  } else {
    float o[16];
#pragma unroll
    for (int j = 0; j < 16; ++j) o[j] = sigmoidf_(v[j]);
    bf16_t* d = (KIND == 6) ? (P.MCb + (long)row * 1024 + (vc0 - 3584)) : (P.MAb + (long)row * 1024 + (vc0 - 4608)); ST8(d, o, 0); ST8(d + 8, o, 8);
  }
}
template <int KIND>
__device__ __forceinline__ void g1_epi(const f32x16 (&acc)[4][2], const G1Ptrs& P, int row0, int vcb, int hi) {
#define G1B(mi, ni) g1_block<KIND>(acc[mi][ni], P, row0 + 32 * (mi), vcb + 32 * (ni), hi); SBAR();
  G1B(0, 0) G1B(1, 0) G1B(2, 0) G1B(3, 0) G1B(0, 1) G1B(1, 1) G1B(2, 1) G1B(3, 1)
#undef G1B
}
__device__ __forceinline__ void phase_gemm1(const Params& p, int g, char* lds, int vid) {
  unsigned char* ws = p.ws;
  const bf16_t* Xb = (g == 0) ? (const bf16_t*)(ws + OFF_XB) : (const bf16_t*)((unsigned char*)p.out + (size_t)TG * DM * 4);
  const bf16_t* W = (const bf16_t*)(ws + OFF_WIN);
  G1Ptrs P;
  P.biasv = (const float*)(ws + OFF_BIASV); P.rope = (const f32x2*)(ws + OFF_ROPE);
  P.U = (bf16_t*)(ws + OFF_U); P.CGb = (bf16_t*)(ws + OFF_CG); P.Qb = (bf16_t*)(ws + OFF_Q); P.Kb = (bf16_t*)(ws + OFF_K);
  P.Vb = (bf16_t*)(ws + OFF_V); P.AGb = (bf16_t*)(ws + OFF_AG); P.MCb = (bf16_t*)(ws + OFF_MC); P.MAb = (bf16_t*)(ws + OFF_MA);
  P.seqmask = (g == 0) ? 16383 : 8191;
  const int tid = otid(), wid = tid >> 6, lane = tid & 63, wr = wid >> 2, wc = wid & 3, r32 = lane & 31, hi = lane >> 5;
  const int xg = vid & 7, jl = vid >> 3;
  for (int rnd = 0; rnd < 5; ++rnd) {
    int pm = 8 * xg + (jl & 7); const int pn = rnd * 4 + (jl >> 3);
    asm volatile("" : "+s"(pm));
    f32x16 acc[4][2];
#pragma unroll
    for (int mi = 0; mi < 4; ++mi)
#pragma unroll
      for (int ni = 0; ni < 2; ++ni) acc[mi][ni] = f32x16{};
    gemm_loop<2>(Xb + (long)pm * 256 * DM, DM, W + (long)pn * 256 * DM, DM, DM / 64, lds, acc);
    const int row0 = pm * 256 + 128 * wr + r32, vcb = pn * 256 + 64 * wc + 16 * hi;
    if (pn < 4) g1_epi<0>(acc, P, row0, vcb, hi);
    else if (pn < 6) g1_epi<1>(acc, P, row0, vcb, hi);
    else if (pn < 8) g1_epi<2>(acc, P, row0, vcb, hi);
    else if (pn < 10) g1_epi<3>(acc, P, row0, vcb, hi);
    else if (pn < 12) g1_epi<4>(acc, P, row0, vcb, hi);
    else if (pn < 14) g1_epi<5>(acc, P, row0, vcb, hi);
    else if (pn < 18) g1_epi<6>(acc, P, row0, vcb, hi);
    else g1_epi<7>(acc, P, row0, vcb, hi);
  }
  {
    int pm = 8 * xg + (jl & 7); const int n0 = 20 * 256 + 128 * (jl >> 3);
    asm volatile("" : "+s"(pm));
    f32x16 acc1[4][1];
#pragma unroll
    for (int mi = 0; mi < 4; ++mi) acc1[mi][0] = f32x16{};
    gemm_loop<1>(Xb + (long)pm * 256 * DM, DM, W + (long)n0 * DM, DM, DM / 64, lds, acc1);
    const int row0 = pm * 256 + 128 * wr + r32, vc0 = n0 + 32 * wc + 16 * hi;
    g1_block<7>(acc1[0][0], P, row0, vc0, hi); SBAR();
    g1_block<7>(acc1[1][0], P, row0 + 32, vc0, hi); SBAR();
    g1_block<7>(acc1[2][0], P, row0 + 64, vc0, hi); SBAR();
    g1_block<7>(acc1[3][0], P, row0 + 96, vc0, hi); SBAR();
  }
}

__device__ __forceinline__ void phase_conv(const Params& p, int g, char* lds) {
  unsigned char* ws = p.ws;
  const bf16_t* U = (const bf16_t*)(ws + OFF_U); const bf16_t* CGb = (const bf16_t*)(ws + OFF_CG); bf16_t* U2 = (bf16_t*)(ws + OFF_U2);
  const int tid = otid(), wid = tid >> 6, lane = tid & 63;
  const int seqlen = (g == 0) ? 16384 : 8192;
  unsigned* IN = (unsigned*)lds;
  float* OUT = (float*)(lds + 65536);
  const int cp = tid & 255, half = tid >> 8;
  float w0[31], w1[31];
#pragma unroll
  for (int j = 0; j < 31; ++j) { f32x2 w = *(const f32x2*)(p.conv_dw + j * 512 + 2 * cp); w0[j] = w[0]; w1[j] = w[1]; }
  const f32x2 cb = *(const f32x2*)(p.conv_dw_b + 2 * cp);
  for (int t = blockIdx.x; t < TG / 32; t += gridDim.x) {
    const int t0 = t * 32, slo = t0 & ~(seqlen - 1), shi = slo + seqlen;
    __syncthreads();
    for (int q = tid; q < 62 * 64; q += NTHR) { int r = q >> 6, c = q & 63; int tok = t0 - 15 + r; u32x4 v = {0u, 0u, 0u, 0u};
      if (tok >= slo && tok < shi) v = *(const u32x4*)(U + (long)tok * 512 + c * 8);
      *(u32x4*)(IN + r * 256 + c * 4) = v; }
    __syncthreads();
    float a0[16], a1[16];
#pragma unroll
    for (int i = 0; i < 16; ++i) { a0[i] = cb[0]; a1[i] = cb[1]; }
#pragma unroll
    for (int ti = 0; ti < 46; ++ti) {
      const unsigned w = IN[(16 * half + ti) * 256 + cp]; const float x0 = bflo(w), x1 = bfhi(w);
#pragma unroll
      for (int to = 0; to < 16; ++to) { const int j = ti - to; if (j >= 0 && j <= 30) { a0[to] = fmaf(w0[j], x0, a0[to]); a1[to] = fmaf(w1[j], x1, a1[to]); } }
    }
#pragma unroll
    for (int to = 0; to < 16; ++to) *(f32x2*)(OUT + (16 * half + to) * 512 + 2 * cp) = f32x2{a0[to], a1[to]};
    __syncthreads();
#pragma unroll
    for (int i = 0; i < 4; ++i) {
      const int tl = wid * 4 + i; const float* src = OUT + tl * 512 + lane * 8;
      f32x4 xa = *(const f32x4*)src, xb = *(const f32x4*)(src + 4);
      float x[8] = {xa[0], xa[1], xa[2], xa[3], xb[0], xb[1], xb[2], xb[3]};
      float s = 0.f;
#pragma unroll
      for (int j = 0; j < 8; ++j) s += x[j];
#pragma unroll
      for (int m = 1; m < 64; m <<= 1) s += __shfl_xor(s, m);
      const float mean = s * (1.f / 512.f); float q = 0.f;
#pragma unroll
      for (int j = 0; j < 8; ++j) { x[j] -= mean; q += x[j] * x[j]; }
#pragma unroll
      for (int m = 1; m < 64; m <<= 1) q += __shfl_xor(q, m);
      const float rstd = rsqrtf(q * (1.f / 512.f) + LN_EPS);
      const long tok = t0 + tl;
      f32x4 g0 = *(const f32x4*)(p.conv_ln_g + lane * 8), g1 = *(const f32x4*)(p.conv_ln_g + lane * 8 + 4);
      f32x4 b0 = *(const f32x4*)(p.conv_ln_b + lane * 8), b1 = *(const f32x4*)(p.conv_ln_b + lane * 8 + 4);
      const float gg[8] = {g0[0], g0[1], g0[2], g0[3], g1[0], g1[1], g1[2], g1[3]}, bb[8] = {b0[0], b0[1], b0[2], b0[3], b1[0], b1[1], b1[2], b1[3]};
      u32x4 cgw = *(const u32x4*)(CGb + tok * 512 + lane * 8);
      const float cgv[8] = {bflo(cgw[0]), bfhi(cgw[0]), bflo(cgw[1]), bfhi(cgw[1]), bflo(cgw[2]), bfhi(cgw[2]), bflo(cgw[3]), bfhi(cgw[3])};
      float o[8];
#pragma unroll
      for (int j = 0; j < 8; ++j) o[j] = siluf_(x[j] * rstd * gg[j] + bb[j]) * cgv[j];
      ST8(U2 + tok * 512 + lane * 8, o, 0);
    }
  }
}

#define KSWZ(row, colB) ((row) * 256 + ((colB) ^ (((row) & 7) << 4)))
constexpr float ATHR = 11.5f;
constexpr int SHM_V = 64 * 128 * 2, SHM_K = 64 * 128 * 2;
__device__ __forceinline__ float vmax3(float a, float b, float c) { float r; asm("v_max3_f32 %0, %1, %2, %3" : "=v"(r) : "v"(a), "v"(b), "v"(c)); return r; }
__device__ __forceinline__ float sm_max_a(const f32x16& p0) {
  float pm = vmax3(p0[0], p0[1], p0[2]);
#pragma unroll
  for (int r = 3; r < 15; r += 2) pm = vmax3(pm, p0[r], p0[r + 1]);
  return pm;
}
template <bool FIRST>
__device__ __forceinline__ void sm_max_b(float pm, f32x16& p0, f32x16& p1, float& m_reg, float& alpha, f32x16& cinit) {
  float pmax = vmax3(pm, p0[15], p1[0]);
#pragma unroll
  for (int r = 1; r < 15; r += 2) pmax = vmax3(pmax, p1[r], p1[r + 1]);
  pmax = fmaxf(pmax, p1[15]);
  { auto rr = __builtin_amdgcn_permlane32_swap(__float_as_uint(pmax), __float_as_uint(pmax), false, false);
    pmax = fmaxf(__uint_as_float(rr[0]), __uint_as_float(rr[1])); }
  alpha = 1.f;
  if (FIRST || !__builtin_expect(__all(pmax <= ATHR), 1)) {
    const float delta = FIRST ? pmax : fmaxf(pmax, 0.f);
    alpha = __builtin_amdgcn_exp2f(-delta); m_reg += delta;
#pragma unroll
    for (int r = 0; r < 16; ++r) { p0[r] -= delta; p1[r] -= delta; cinit[r] = -m_reg; }
  }
}
__device__ __forceinline__ void sm_exp(f32x16& p) {
#pragma unroll
  for (int r = 0; r < 16; ++r) p[r] = __builtin_amdgcn_exp2f(p[r]);
}
__device__ __forceinline__ void finishSM(f32x16& p0, f32x16& p1, float alpha, float& l_reg, bf16x8& pa0, bf16x8& pa1, bf16x8& pa2, bf16x8& pa3) {
  float ps = 0, ps2 = 0;
#pragma unroll
  for (int r = 0; r < 16; ++r) { ps += p0[r]; ps2 += p1[r]; }
  ps += ps2;
  { auto rr = __builtin_amdgcn_permlane32_swap(__float_as_uint(ps), __float_as_uint(ps), false, false);
    ps = __uint_as_float(rr[0]) + __uint_as_float(rr[1]); }
  l_reg = l_reg * alpha + ps;
#define PK4(P, BASE, OUT) do { u32x4 w = {cvtpk(P[BASE + 0], P[BASE + 1]), cvtpk(P[BASE + 2], P[BASE + 3]), cvtpk(P[BASE + 4], P[BASE + 5]), cvtpk(P[BASE + 6], P[BASE + 7])}; \
    OUT = *reinterpret_cast<bf16x8*>(&w); } while (0)
  PK4(p0, 0, pa0); PK4(p0, 8, pa1); PK4(p1, 0, pa2); PK4(p1, 8, pa3);
#undef PK4
}
__device__ __forceinline__ void qkt(f32x16& p0, f32x16& p1, const char* Ks, const bf16x8* qr, int r32, int hi, int comp, const f32x16& cinit) {
#pragma unroll
  for (int d0 = 0; d0 < 4; ++d0) { int cb = (comp * 64 + d0 * 16 + hi * 8) * 2;
    bf16x8 b0 = *reinterpret_cast<const bf16x8*>(Ks + KSWZ(r32, cb));
    bf16x8 b1 = *reinterpret_cast<const bf16x8*>(Ks + KSWZ(32 + r32, cb));
    if (d0 == 0) { p0 = __builtin_amdgcn_mfma_f32_32x32x16_bf16(b0, qr[d0], cinit, 0, 0, 0); p1 = __builtin_amdgcn_mfma_f32_32x32x16_bf16(b1, qr[d0], cinit, 0, 0, 0); }
    else { p0 = __builtin_amdgcn_mfma_f32_32x32x16_bf16(b0, qr[d0], p0, 0, 0, 0); p1 = __builtin_amdgcn_mfma_f32_32x32x16_bf16(b1, qr[d0], p1, 0, 0, 0); } }
}
__device__ __forceinline__ int v_st(int k, int c) { const int kk = (k & ~0xC) | ((k & 4) << 1) | ((k & 8) >> 1); return ((kk >> 3) * 4 + (c >> 5)) * 512 + ((kk & 7) * 32 + (c & 31)) * 2; }
__device__ __forceinline__ int v_rd_base(int lane) { return ((lane & 3) << 3) | (((lane >> 2) & 3) << 6) | (((lane >> 4) & 1) << 5) | (((lane >> 5) & 1) << 8); }
constexpr int v_rd_off(int d0, int ks, int half) { return d0 * 512 + ks * 4096 + half * 2048; }
template <int OFF> __device__ __forceinline__ s16x4 tr_read(int vb) {
  s16x4 r; asm volatile("ds_read_b64_tr_b16 %0, %1 offset:%2" : "=&v"(r) : "v"(vb), "i"(OFF) : "memory"); return r;
}
template <int D0> __device__ __forceinline__ void pv_one(f32x16& od, int vb, bf16x8 pa0, bf16x8 pa1, bf16x8 pa2, bf16x8 pa3) {
  const s16x4 l0 = tr_read<v_rd_off(D0, 0, 0)>(vb), h0 = tr_read<v_rd_off(D0, 0, 1)>(vb), l1 = tr_read<v_rd_off(D0, 1, 0)>(vb), h1 = tr_read<v_rd_off(D0, 1, 1)>(vb);
  const s16x4 l2 = tr_read<v_rd_off(D0, 2, 0)>(vb), h2 = tr_read<v_rd_off(D0, 2, 1)>(vb), l3 = tr_read<v_rd_off(D0, 3, 0)>(vb), h3 = tr_read<v_rd_off(D0, 3, 1)>(vb);
  asm volatile("s_waitcnt lgkmcnt(0)" ::: "memory"); SBAR();
#define PK(L, H) (bf16x8){L[0], L[1], L[2], L[3], H[0], H[1], H[2], H[3]}
  od = __builtin_amdgcn_mfma_f32_32x32x16_bf16(pa0, PK(l0, h0), od, 0, 0, 0);
  od = __builtin_amdgcn_mfma_f32_32x32x16_bf16(pa1, PK(l1, h1), od, 0, 0, 0);
  od = __builtin_amdgcn_mfma_f32_32x32x16_bf16(pa2, PK(l2, h2), od, 0, 0, 0);
  od = __builtin_amdgcn_mfma_f32_32x32x16_bf16(pa3, PK(l3, h3), od, 0, 0, 0);
#undef PK
}

typedef float f32x2_t_ __attribute__((ext_vector_type(2))); typedef __bf16 bf16x2_t_ __attribute__((ext_vector_type(2)));
__device__ __forceinline__ unsigned cvtpk_s(float lo, float hi) { f32x2_t_ v = {lo, hi}; bf16x2_t_ b = __builtin_convertvector(v, bf16x2_t_); return __builtin_bit_cast(unsigned, b); }
typedef __attribute__((address_space(3))) const char* lds_cptr;
typedef short v4i16_t_ __attribute__((ext_vector_type(4)));
__device__ __forceinline__ s16x4 vtr(lds_cptr p) { return __builtin_bit_cast(s16x4, __builtin_amdgcn_ds_read_tr16_b64_v4i16((__attribute__((address_space(3))) v4i16_t_*)p)); }
__device__ __forceinline__ void attn_unit(const bf16_t* __restrict__ Qb, const bf16_t* __restrict__ Kh, const bf16_t* __restrict__ Vh, const bf16_t* __restrict__ AGb,
                                          bf16_t* __restrict__ O2b, int seq, float lam, const float* __restrict__ subg, char* lds) {
  constexpr int LDK = 512;
  const int tid = otid(), wid = tid >> 6, lane = tid & 63, r32 = lane & 31, hi = lane >> 5, rowgrp = wid & 3, comp = wid >> 2;
  constexpr int BUFB = SHM_V + SHM_K;
  float* wsl = (float*)(lds + 3 * BUFB) + wid * 64; float* li_l = wsl; float* al_l = wsl + 32;
  float m_reg = 0.f, l_reg = 0; f32x16 o[4] = {}; bf16x8 qr[4]; f32x16 cinit = {};
  const int vb0 = (int)(uintptr_t)lds + v_rd_base(lane);
  const int wid_s = __builtin_amdgcn_readfirstlane(wid);
  const bf16_t* ksrc[2]; const bf16_t* vsrc[2];
#pragma unroll
  for (int i = 0; i < 2; ++i) {
    const int pk = 2 * wid + i, row = 4 * pk + (lane >> 4), chunk = (lane & 15) ^ (row & 7);
    ksrc[i] = Kh + (long)row * LDK + chunk * 8;
    const int q = 64 * pk + lane, sti = q >> 5, kkl = (q >> 2) & 7, cq = q & 3, kk = (sti >> 2) * 8 + kkl, c = (sti & 3) * 32 + cq * 8, k = kk;
    vsrc[i] = Vh + (long)k * LDK + c;
  }
#define DMA_TILE(t, ob) do { char* d_ = lds + (ob) + wid_s * 2048; const long to_ = (long)(t) * 64 * LDK;                                  \
    __builtin_amdgcn_global_load_lds((const unsigned*)(vsrc[0] + to_), (unsigned*)(d_), 16, 0, 0);                                              \
    __builtin_amdgcn_global_load_lds((const unsigned*)(vsrc[1] + to_), (unsigned*)(d_ + 1024), 16, 0, 0);                                       \
    __builtin_amdgcn_global_load_lds((const unsigned*)(ksrc[0] + to_), (unsigned*)(d_ + SHM_V), 16, 0, 0);                                      \
    __builtin_amdgcn_global_load_lds((const unsigned*)(ksrc[1] + to_), (unsigned*)(d_ + SHM_V + 1024), 16, 0, 0); } while (0)
#define TILE_BAR() do { asm volatile("s_waitcnt vmcnt(0) lgkmcnt(0)" ::: "memory"); __builtin_amdgcn_s_barrier(); asm volatile("" ::: "memory"); } while (0)
#define RESC(a) do { if (__any((a) < 1.f)) { if (hi == 0) al_l[r32] = (a); asm volatile("s_waitcnt lgkmcnt(0)" ::: "memory"); \
    _Pragma("unroll") for (int d = 0; d < 4; ++d) _Pragma("unroll") for (int r = 0; r < 16; ++r) o[d][r] *= al_l[crow(r, hi)]; } } while (0)
  DMA_TILE(0, 0); DMA_TILE(1, BUFB);
  const bf16_t* Qw = Qb + (long)(rowgrp * 32 + r32) * LDK + comp * 64 + hi * 8;
#pragma unroll
  for (int d0 = 0; d0 < 4; ++d0) qr[d0] = *(const bf16x8*)(Qw + d0 * 16);
  f32x16 pA0, pA1, pB0, pB1; float alA, alB; bf16x8 pa0, pa1, pa2, pa3; const int NT = seq / 64;
  float pmx;
#define PV_SM(VB, P0, P1, AL) do {                                                                    \
    pv_one<0>(o[0], VB, pa0, pa1, pa2, pa3); pmx = sm_max_a(P0);                                       \
    pv_one<1>(o[1], VB, pa0, pa1, pa2, pa3); sm_max_b<false>(pmx, P0, P1, m_reg, AL, cinit);           \
    pv_one<2>(o[2], VB, pa0, pa1, pa2, pa3); sm_exp(P0);                                               \
    pv_one<3>(o[3], VB, pa0, pa1, pa2, pa3); sm_exp(P1); } while (0)
  TILE_BAR();
  qkt(pA0, pA1, lds + SHM_V, qr, r32, hi, comp, cinit); pmx = sm_max_a(pA0); sm_max_b<true>(pmx, pA0, pA1, m_reg, alA, cinit); alA = 1.f; sm_exp(pA0); sm_exp(pA1);
  int obp = 0, obc = BUFB, obn = 2 * BUFB;
  const int kx0 = r32 * 256 + ((comp * 128 + 0 * 32 + hi * 16) ^ ((r32 & 7) << 4)), kx1 = r32 * 256 + ((comp * 128 + 1 * 32 + hi * 16) ^ ((r32 & 7) << 4));
  const int kx2 = r32 * 256 + ((comp * 128 + 2 * 32 + hi * 16) ^ ((r32 & 7) << 4)), kx3 = r32 * 256 + ((comp * 128 + 3 * 32 + hi * 16) ^ ((r32 & 7) << 4));
  const int vrb = v_rd_base(lane);
#define PIN(x) asm volatile("" : "+v"(x))
#define MX3(a, b, c) __builtin_fmaxf(__builtin_fmaxf((a), (b)), (c))
#define KF(off) (*reinterpret_cast<const bf16x8*>(kb_ + (off)))
#define KP(p) (*reinterpret_cast<const bf16x8*>(p))
#define MF(a, b, c) __builtin_amdgcn_mfma_f32_32x32x16_bf16(a, b, c, 0, 0, 0)
#define VRD(i) do { vlo[i] = vtr(vp_ + v_rd_off((i) & 3, (i) >> 2, 0)); vhi[i] = vtr(vp_ + v_rd_off((i) & 3, (i) >> 2, 1)); } while (0)
#define VFR(i) (bf16x8){vlo[i][0], vlo[i][1], vlo[i][2], vlo[i][3], vhi[i][0], vhi[i][1], vhi[i][2], vhi[i][3]}
#define SWP(OUT) do { u32x4 w_ = {ca0, ca1, cb0, cb1}; OUT = *reinterpret_cast<bf16x8*>(&w_); } while (0)
#define GQA(MFS, P, B) do { MFS; sacc += P[B]; sacc += P[B + 1]; sacc += P[B + 2]; sacc += P[B + 3]; PIN(sacc); ca0 = cvtpk_s(P[B], P[B + 1]); ca1 = cvtpk_s(P[B + 2], P[B + 3]); PIN(ca0); PIN(ca1); SBAR(); } while (0)
#define GQB(MFS, P, B, OUT) do { MFS; sacc += P[B]; sacc += P[B + 1]; sacc += P[B + 2]; sacc += P[B + 3]; PIN(sacc); cb0 = cvtpk_s(P[B], P[B + 1]); cb1 = cvtpk_s(P[B + 2], P[B + 3]); SWP(OUT); PIN(OUT); SBAR(); } while (0)
#define GPM(i, PAk, X0, X1, X2, X3) do { if ((i) + 2 < 16) VRD((i) + 2); o[(i) & 3] = MF(PAk, VFR(i), o[(i) & 3]); rm_ = MX3(rm_, X0, X1); rm_ = MX3(rm_, X2, X3); PIN(rm_); SBAR(); } while (0)
#define GPE(i, PAk, X, B) do { if ((i) + 2 < 16) VRD((i) + 2); o[(i) & 3] = MF(PAk, VFR(i), o[(i) & 3]); X[B] = __builtin_amdgcn_exp2f(X[B]); X[B + 1] = __builtin_amdgcn_exp2f(X[B + 1]); \
    X[B + 2] = __builtin_amdgcn_exp2f(X[B + 2]); X[B + 3] = __builtin_amdgcn_exp2f(X[B + 3]); PIN(X); SBAR(); } while (0)
#define GPX(i, PAk, X, B) do { if ((i) + 2 < 16) VRD((i) + 2); o[(i) & 3] = MF(PAk, VFR(i), o[(i) & 3]); X[B] = __builtin_amdgcn_exp2f(X[B]); X[B + 1] = __builtin_amdgcn_exp2f(X[B + 1]); PIN(X); SBAR(); } while (0)
#define STEP(C0, C1, P0, P1, AL) do { SBAR();                                                                                    \
    const char* kb_ = lds + obc + SHM_V; const lds_cptr vp_ = (lds_cptr)lds + obp + vrb;                                            \
    s16x4 vlo[16], vhi[16]; unsigned ca0, ca1, cb0, cb1; float sacc = 0.f;                                                        \
    const char* k0_ = kb_ + kx0; const char* k1_ = kb_ + kx1; const char* k2_ = kb_ + kx2; const char* k3_ = kb_ + kx3;                 \
    const bf16x8 kf0 = KP(k0_), kf1 = KP(k0_ + 8192), kf2 = KP(k1_), kf3 = KP(k1_ + 8192); SBAR();                                \
    GQA(C0 = MF(kf0, qr[0], cinit), P0, 0);                                                                                       \
    const bf16x8 kf4 = KP(k2_), kf5 = KP(k2_ + 8192), kf6 = KP(k3_), kf7 = KP(k3_ + 8192);                                        \
    GQB(C1 = MF(kf1, qr[0], cinit), P0, 4, pa0);                                                                                  \
    GQA(C0 = MF(kf2, qr[1], C0), P0, 8);  GQB(C1 = MF(kf3, qr[1], C1), P0, 12, pa1);                                              \
    VRD(0);                                                                                                                       \
    GQA(C0 = MF(kf4, qr[2], C0), P1, 0);  GQB(C1 = MF(kf5, qr[2], C1), P1, 4, pa2);                                               \
    VRD(1);                                                                                                                       \
    GQA(C0 = MF(kf6, qr[3], C0), P1, 8);  GQB(C1 = MF(kf7, qr[3], C1), P1, 12, pa3);                                              \
    float ps_; { auto rr_ = __builtin_amdgcn_permlane32_swap(__float_as_uint(sacc), __float_as_uint(sacc), false, false);        \
      ps_ = __uint_as_float(rr_[0]) + __uint_as_float(rr_[1]); }                                                                  \
    l_reg += ps_; AL = 1.f;                                                                                                       \
    if (!__builtin_expect(__all(ps_ <= PTHR), 1)) { const float dl_ = fmaxf(__log2f(ps_), 0.f); AL = __builtin_amdgcn_exp2f(-dl_); m_reg += dl_;   \
      _Pragma("unroll") for (int r = 0; r < 16; ++r) { C0[r] -= dl_; C1[r] -= dl_; cinit[r] = -m_reg; } }                            \
    SBAR();                                                                                                                       \
    GPX(0, pa0, C0, 0);  GPX(1, pa0, C0, 2);  GPX(2, pa0, C0, 4);   GPX(3, pa0, C0, 6);                                           \
    GPX(4, pa1, C0, 8);  GPX(5, pa1, C0, 10); GPX(6, pa1, C0, 12);  GPX(7, pa1, C0, 14);                                          \
    GPX(8, pa2, C1, 0);  GPX(9, pa2, C1, 2);  GPX(10, pa2, C1, 4);  GPX(11, pa2, C1, 6);                                          \
    GPX(12, pa3, C1, 8); GPX(13, pa3, C1, 10); GPX(14, pa3, C1, 12); GPX(15, pa3, C1, 14);                                        \
    if (__any(AL < 1.f)) { if (hi == 0) al_l[r32] = AL; asm volatile("s_waitcnt lgkmcnt(0)" ::: "memory"); l_reg *= AL;          \
      _Pragma("unroll") for (int d = 0; d < 4; ++d) _Pragma("unroll") for (int r = 0; r < 16; ++r) o[d][r] *= al_l[crow(r, hi)]; } \
  } while (0)
  constexpr float PTHR = 2896.3f;
  { float alS;
  for (int j = 1; j + 1 < NT; j += 2) {
    DMA_TILE(j + 1, obn);
    STEP(pB0, pB1, pA0, pA1, alS);
    TILE_BAR();
    { const int t_ = obp; obp = obc; obc = obn; obn = t_; }
    if (j + 2 < NT) DMA_TILE(j + 2, obn);
    STEP(pA0, pA1, pB0, pB1, alS);
    TILE_BAR();
    { const int t_ = obp; obp = obc; obc = obn; obn = t_; }
  } }
  alA = 1.f;
#undef GPX
#undef STEP
#undef GPE
#undef GPM
#undef GQB
#undef GQA
#undef SWP
#undef VFR
#undef VRD
#undef MF
#undef KF
#undef KP
#undef PIN
#undef MX3
  SBAR(); qkt(pB0, pB1, lds + obc + SHM_V, qr, r32, hi, comp, cinit);
  finishSM(pA0, pA1, alA, l_reg, pa0, pa1, pa2, pa3); SBAR();
  PV_SM(vb0 + obp, pB0, pB1, alB);
  RESC(alB);
  finishSM(pB0, pB1, alB, l_reg, pa0, pa1, pa2, pa3); SBAR();
  pv_one<0>(o[0], vb0 + obc, pa0, pa1, pa2, pa3); pv_one<1>(o[1], vb0 + obc, pa0, pa1, pa2, pa3);
  pv_one<2>(o[2], vb0 + obc, pa0, pa1, pa2, pa3); pv_one<3>(o[3], vb0 + obc, pa0, pa1, pa2, pa3);
#undef PV_SM
#undef DMA_TILE
#undef TILE_BAR
#undef RESC
  asm volatile("s_waitcnt vmcnt(0)" ::: "memory");
  __syncthreads();
  float* X = (float*)lds;
  if (hi == 0) li_l[r32] = l_reg;
  asm volatile("s_waitcnt lgkmcnt(0)" ::: "memory");
  float rli[16];
#pragma unroll
  for (int r = 0; r < 16; ++r) rli[r] = __builtin_amdgcn_rcpf(li_l[crow(r, hi)]);
  if (comp == 0) {
#pragma unroll
    for (int r = 0; r < 16; ++r)
#pragma unroll
      for (int d0 = 0; d0 < 4; ++d0) X[(rowgrp * 32 + crow(r, hi)) * 128 + d0 * 32 + r32] = o[d0][r] * rli[r];
  }
  __syncthreads();
  if (comp == 1) {
#pragma unroll
    for (int r = 0; r < 16; ++r)
#pragma unroll
      for (int d0 = 0; d0 < 4; ++d0) { float* xp = X + (rowgrp * 32 + crow(r, hi)) * 128 + d0 * 32 + r32; *xp = *xp - lam * (o[d0][r] * rli[r]); }
  }
  __syncthreads();
  {
    const int row = tid >> 2, c0 = (tid & 3) * 32;
    float v[32]; float ss = 0.f;
#pragma unroll
    for (int i = 0; i < 8; ++i) { f32x4 x4 = *(const f32x4*)(X + row * 128 + c0 + 4 * i); v[4 * i] = x4[0]; v[4 * i + 1] = x4[1]; v[4 * i + 2] = x4[2]; v[4 * i + 3] = x4[3]; }
#pragma unroll
    for (int i = 0; i < 32; ++i) ss += v[i] * v[i];
    ss += __shfl_xor(ss, 1); ss += __shfl_xor(ss, 2);
    const float rs = rsqrtf(ss * (1.f / 128.f) + LN_EPS) * (1.f - LAM_INIT);
#pragma unroll
    for (int i = 0; i < 4; ++i) {
      u32x4 gw = *(const u32x4*)(AGb + (long)row * 512 + c0 + 8 * i);
      f32x4 s0 = *(const f32x4*)(subg + c0 + 8 * i), s1 = *(const f32x4*)(subg + c0 + 8 * i + 4);
      float ov[8];
      ov[0] = v[8 * i + 0] * rs * s0[0] * bflo(gw[0]); ov[1] = v[8 * i + 1] * rs * s0[1] * bfhi(gw[0]);
      ov[2] = v[8 * i + 2] * rs * s0[2] * bflo(gw[1]); ov[3] = v[8 * i + 3] * rs * s0[3] * bfhi(gw[1]);
      ov[4] = v[8 * i + 4] * rs * s1[0] * bflo(gw[2]); ov[5] = v[8 * i + 5] * rs * s1[1] * bfhi(gw[2]);
      ov[6] = v[8 * i + 6] * rs * s1[2] * bflo(gw[3]); ov[7] = v[8 * i + 7] * rs * s1[3] * bfhi(gw[3]);
      ST8(O2b + (long)row * 512 + c0 + 8 * i, ov, 0);
    }
  }
  __syncthreads();
}

__device__ __forceinline__ void phase_attn(const Params& p, int g, char* lds, int vid) {
  unsigned char* ws = p.ws;
  const bf16_t* Qb = (const bf16_t*)(ws + OFF_Q); const bf16_t* Kb = (const bf16_t*)(ws + OFF_K); const bf16_t* Vb = (const bf16_t*)(ws + OFF_V);
  const bf16_t* AGb = (const bf16_t*)(ws + OFF_AG); bf16_t* O2 = (bf16_t*)(ws + OFF_O2);
  const float lam = *(const float*)(ws + OFF_MISC);
  const int x = vid & 7, jj = vid >> 3, nper = 32;
  for (int u = jj; u < 64; u += nper) {
    int head, seq0, seq, qb;
    if (g == 0) { head = x >> 1; seq0 = 0; seq = 16384; qb = (x & 1) * 64 + u; }
    else { head = x & 3; seq0 = (x >> 2) * 8192; seq = 8192; qb = u; }
    const long qrow = seq0 + (long)qb * 128;
    attn_unit(Qb + qrow * 512 + head * 128, Kb + (long)seq0 * 512 + head * 128, Vb + (long)seq0 * 512 + head * 128, AGb + qrow * 512 + head * 128,
              O2 + qrow * 512 + head * 128, seq, lam, p.subln_g, lds);
  }
}

__device__ __forceinline__ void g2_block(const f32x16& a1, const f32x16& a2, const bf16_t* MCb, const bf16_t* MAb, bf16_t* MG, const float* bcp, long row, int c0) {
  u32x4 mc0 = *(const u32x4*)(MCb + row * 1024 + c0), mc1 = *(const u32x4*)(MCb + row * 1024 + c0 + 8);
  u32x4 ma0 = *(const u32x4*)(MAb + row * 1024 + c0), ma1 = *(const u32x4*)(MAb + row * 1024 + c0 + 8);
  float bc[16];
#pragma unroll
  for (int j = 0; j < 4; ++j) { f32x4 b4 = *(const f32x4*)(bcp + c0 + 4 * j); bc[4 * j] = b4[0]; bc[4 * j + 1] = b4[1]; bc[4 * j + 2] = b4[2]; bc[4 * j + 3] = b4[3]; }
  float o[16];
#pragma unroll
  for (int j = 0; j < 4; ++j) {
    o[2 * j] = bflo(mc0[j]) * (a1[2 * j] + bc[2 * j]) + bflo(ma0[j]) * a2[2 * j];
    o[2 * j + 1] = bfhi(mc0[j]) * (a1[2 * j + 1] + bc[2 * j + 1]) + bfhi(ma0[j]) * a2[2 * j + 1];
    o[8 + 2 * j] = bflo(mc1[j]) * (a1[8 + 2 * j] + bc[8 + 2 * j]) + bflo(ma1[j]) * a2[8 + 2 * j];
    o[8 + 2 * j + 1] = bfhi(mc1[j]) * (a1[8 + 2 * j + 1] + bc[8 + 2 * j + 1]) + bfhi(ma1[j]) * a2[8 + 2 * j + 1];
  }
  ST8(MG + row * 1024 + c0, o, 0); ST8(MG + row * 1024 + c0 + 8, o, 8);
}
__device__ __forceinline__ void phase_gemm2(const Params& p, char* lds, int vid) {
  unsigned char* ws = p.ws;
  const bf16_t* U2 = (const bf16_t*)(ws + OFF_U2); const bf16_t* O2 = (const bf16_t*)(ws + OFF_O2);
  const bf16_t* Wcp = (const bf16_t*)(ws + OFF_WCP); const bf16_t* Wao = (const bf16_t*)(ws + OFF_WAO);
  const bf16_t* MCb = (const bf16_t*)(ws + OFF_MC); const bf16_t* MAb = (const bf16_t*)(ws + OFF_MA); bf16_t* MG = (bf16_t*)(ws + OFF_XB);
  const int tid = otid(), wid = tid >> 6, lane = tid & 63, wr = wid >> 2, wc = wid & 3, r32 = lane & 31, hi = lane >> 5;
  const int xg = vid & 7, jl = vid >> 3;
  for (int rnd = 0; rnd < 2; ++rnd) {
    int pm = 8 * xg + (jl & 7); const int pn = rnd * 4 + (jl >> 3);
    asm volatile("" : "+s"(pm));
    f32x16 a1[4][1], a2[4][1];
#pragma unroll
    for (int mi = 0; mi < 4; ++mi) { a1[mi][0] = f32x16{}; a2[mi][0] = f32x16{}; }
    gemm_loop<1>(U2 + (long)pm * 256 * 512, 512, Wcp + (long)pn * 128 * 512, 512, 8, lds, a1);
    gemm_loop<1>(O2 + (long)pm * 256 * 512, 512, Wao + (long)pn * 128 * 512, 512, 8, lds, a2);
    const int c0 = pn * 128 + 32 * wc + 16 * hi;
    const long row0 = pm * 256 + 128 * wr + r32;
    g2_block(a1[0][0], a2[0][0], MCb, MAb, MG, p.b_cp, row0, c0); SBAR();
    g2_block(a1[1][0], a2[1][0], MCb, MAb, MG, p.b_cp, row0 + 32, c0); SBAR();
    g2_block(a1[2][0], a2[2][0], MCb, MAb, MG, p.b_cp, row0 + 64, c0); SBAR();
    g2_block(a1[3][0], a2[3][0], MCb, MAb, MG, p.b_cp, row0 + 96, c0); SBAR();
  }
}

__device__ __forceinline__ void phase_gemm3(const Params& p, int g, char* lds, int vid) {
  unsigned char* ws = p.ws;
  const bf16_t* MG = (const bf16_t*)(ws + OFF_XB); const bf16_t* Wo = (const bf16_t*)(ws + OFF_WOUT);
  const float* x = p.x[g]; float* out = p.out + (size_t)g * TG * DM;
  const int tid = otid(), wid = tid >> 6, lane = tid & 63, wr = wid >> 2, wc = wid & 3, r32 = lane & 31, hi = lane >> 5;
  const int xg = vid & 7, jl = vid >> 3;
  {
    const int pm = 8 * xg + (jl & 7), pn = (jl >> 3);
    f32x16 acc[4][2];
#pragma unroll
    for (int mi = 0; mi < 4; ++mi)
#pragma unroll
      for (int ni = 0; ni < 2; ++ni) acc[mi][ni] = f32x16{};
    gemm_loop<2>(MG + (long)pm * 256 * DM, DM, Wo + (long)pn * 256 * DM, DM, DM / 64, lds, acc);
#pragma unroll
    for (int ni = 0; ni < 2; ++ni) {
      const int c0 = pn * 256 + 64 * wc + 32 * ni + 16 * hi;
      f32x4 bo[4];
#pragma unroll
      for (int j = 0; j < 4; ++j) bo[j] = *(const f32x4*)(p.b_out + c0 + 4 * j);
#pragma unroll
      for (int mi = 0; mi < 4; ++mi) {
        const long row = pm * 256 + 128 * wr + 32 * mi + r32;
#pragma unroll
        for (int j = 0; j < 4; ++j) {
          f32x4 xv = *(const f32x4*)(x + row * DM + c0 + 4 * j); f32x4 r;
          r[0] = acc[mi][ni][4 * j] + bo[j][0] + ALPHA * xv[0]; r[1] = acc[mi][ni][4 * j + 1] + bo[j][1] + ALPHA * xv[1];
          r[2] = acc[mi][ni][4 * j + 2] + bo[j][2] + ALPHA * xv[2]; r[3] = acc[mi][ni][4 * j + 3] + bo[j][3] + ALPHA * xv[3];
          *(f32x4*)(out + row * DM + c0 + 4 * j) = r;
        }
      }
    }
  }
}

namespace pg8 {
#define PG8_LAS __attribute__((address_space(3)))
constexpr int BM = 256, BK = 64, HALF = 128, HTB = HALF * BK * 2, STAGE_BYTES = 8 * HTB;
__device__ __forceinline__ int lds_byte(int r, int c) { const int st = (r >> 4) * 2 + (c >> 5), rr = r & 15, cc = c & 31, ob = rr * 64 + cc * 2; return st * 1024 + (ob ^ (((ob >> 9) & 1) << 5)); }
__device__ __forceinline__ void stage_rc(int b, int& R, int& C) { const int st = b / 1024, sb = b % 1024, swz = sb ^ (((sb >> 9) & 1) << 5); R = (st >> 1) * 16 + swz / 64; C = (st & 1) * 32 + (swz % 64) / 2; }
__device__ __forceinline__ int perm32(int rho) { const int n = rho >> 4, i = rho & 15; return 8 * (i >> 2) + 4 * n + (i & 3); }
struct Unit { int pm, pn; };
struct Gemm { const bf16_t* A; const bf16_t* Bt; int M, N, K; };
struct GroupOrder {
  int xg, jl, npn;
  __device__ __forceinline__ bool next(int i, Unit& u) const { int pm_ = 8 * xg + (jl & 7); asm volatile("" : "+s"(pm_));
    u.pm = pm_; u.pn = 4 * i + (jl >> 3); return u.pn < npn; }
  __device__ __forceinline__ void a_ready(const Unit&) const {}
  __device__ __forceinline__ void done(const Unit&) const {}
};
template <class Epi, class Sched, bool ALIGN_EPI = false, bool SP2 = false>
__device__ __forceinline__ void gemm_phase(PG8_LAS unsigned char* lds, const Gemm g, const Sched& S, const Epi& E) {
    const int tid = otid(), wid = __builtin_amdgcn_readfirstlane(tid >> 6), lane = tid & 63, wr = wid >> 2, wc = wid & 3, fr = lane & 15, fq = lane >> 4;
    const int K = g.K, nt = K / BK;
    unsigned voffA[2], voffB[2];
#pragma unroll
    for (int i = 0; i < 2; ++i) { int R, C; stage_rc(tid * 16 + i * 8192, R, C); const int Rb = Epi::PERM ? ((R & ~31) + perm32(R & 31)) : R;
        voffA[i] = (unsigned)(R * K + C) * 2u; voffB[i] = (unsigned)(Rb * K + C) * 2u; }
    const size_t kstep = (size_t)(BK * 2);
    const size_t hstep = (size_t)HALF * K * 2;
    const size_t tstep = 2 * hstep;
    const unsigned ldsw = (unsigned)wid * 1024u;
    const int aoff = lds_byte(wr * 64 + fr, fq * 8), boff = lds_byte(wc * 32 + fr, fq * 8);
#define PG8_SA(b, h) (((b) * 2 + (h)) * HTB)
#define PG8_SB(b, h) ((4 + (b) * 2 + (h)) * HTB)
#define PG8_STAGE(bufoff, gbase, voff) do { _Pragma("unroll") for (int _i = 0; _i < 2; ++_i) \
        __builtin_amdgcn_global_load_lds((const unsigned*)((const char*)(gbase) + (voff)[_i]), (PG8_LAS unsigned*)(lds + (bufoff) + ldsw + _i * 8192), 16, 0, 0); } while (0)
#define PG8_LDA(dst, b, h) do { _Pragma("unroll") for (int m = 0; m < 4; ++m) _Pragma("unroll") for (int k = 0; k < 2; ++k) dst[m][k] = *(const PG8_LAS bf16x8*)(lds + PG8_SA(b, h) + aoff + m * 2048 + k * 1024); } while (0)
#define PG8_LDB(dst, b, h) do { _Pragma("unroll") for (int n = 0; n < 2; ++n) _Pragma("unroll") for (int k = 0; k < 2; ++k) dst[n][k] = *(const PG8_LAS bf16x8*)(lds + PG8_SB(b, h) + boff + n * 2048 + k * 1024); } while (0)
#define PG8_MMA(ai, bj, At, Bt) do { __builtin_amdgcn_s_setprio(1); _Pragma("unroll") for (int m = 0; m < 4; ++m) _Pragma("unroll") for (int n = 0; n < 2; ++n) _Pragma("unroll") for (int k = 0; k < 2; ++k) \
        acc[ai][bj][m][n] = __builtin_amdgcn_mfma_f32_16x16x32_bf16(Bt[n][k], At[m][k], acc[ai][bj][m][n], 0, 0, 0); __builtin_amdgcn_s_setprio(0); } while (0)
#define PG8_WAIT_V(n) asm volatile("s_waitcnt vmcnt(" #n ")" ::: "memory")
#define PG8_WAIT_L(n) asm volatile("s_waitcnt lgkmcnt(" #n ")" ::: "memory")
#define PG8_BAR __builtin_amdgcn_s_barrier()
#define PG8_SCHED __builtin_amdgcn_sched_barrier(0)
    Unit cur, nxt; int ui = 0;
    if (!S.next(0, cur)) return;
    f32x4 acc[2][2][4][2];
#pragma unroll
    for (int a = 0; a < 2; ++a)
#pragma unroll
        for (int b = 0; b < 2; ++b)
#pragma unroll
            for (int m = 0; m < 4; ++m)
#pragma unroll
                for (int n = 0; n < 2; ++n) acc[a][b][m][n] = (f32x4){0.f, 0.f, 0.f, 0.f};
    bf16x8 At[4][2], B0[2][2], B1[2][2];
    const char* cA = (const char*)g.A + (size_t)cur.pm * tstep; const char* cB = (const char*)g.Bt + (size_t)cur.pn * tstep;
    S.a_ready(cur);
    if constexpr (SP2) {
        PG8_STAGE(PG8_SB(0, 0), cB, voffB); PG8_STAGE(PG8_SB(0, 1), cB + hstep, voffB); PG8_STAGE(PG8_SA(0, 0), cA, voffA); PG8_STAGE(PG8_SA(0, 1), cA + hstep, voffA);
        if (wr == 1) PG8_BAR;
        PG8_WAIT_V(2); PG8_BAR;
        PG8_STAGE(PG8_SB(1, 0), cB + kstep, voffB); PG8_STAGE(PG8_SA(1, 0), cA + kstep, voffA); PG8_STAGE(PG8_SB(1, 1), cB + hstep + kstep, voffB);
        PG8_WAIT_V(6); PG8_BAR;
    } else {
        PG8_STAGE(PG8_SB(0, 0), cB, voffB); PG8_STAGE(PG8_SA(0, 0), cA, voffA); PG8_STAGE(PG8_SB(0, 1), cB + hstep, voffB); PG8_STAGE(PG8_SA(0, 1), cA + hstep, voffA);
        if (wr == 1) PG8_BAR;
        PG8_WAIT_V(4); PG8_BAR;
        PG8_STAGE(PG8_SB(1, 0), cB + kstep, voffB); PG8_STAGE(PG8_SA(1, 0), cA + kstep, voffA); PG8_STAGE(PG8_SB(1, 1), cB + hstep + kstep, voffB);
        PG8_WAIT_V(6); PG8_BAR;
    }
    for (;;) {
        const bool has_next = S.next(ui + 1, nxt);
        const char* nA = has_next ? (const char*)g.A + (size_t)nxt.pm * tstep : cA; const char* nB = has_next ? (const char*)g.Bt + (size_t)nxt.pn * tstep : cB;
        for (int t = 0; t < nt; t += 2) {
            const bool last = (t == nt - 2);
            const char* a1 = cA + (size_t)(t + 1) * kstep;
            const char* a2 = last ? nA : cA + (size_t)(t + 2) * kstep; const char* b2 = last ? nB : cB + (size_t)(t + 2) * kstep;
            const char* a3 = a2 + kstep; const char* b3 = b2 + kstep;
            if (last && has_next) S.a_ready(nxt);
            if constexpr (SP2) {
            PG8_LDB(B0, 0, 0); PG8_LDB(B1, 0, 1); PG8_SCHED; PG8_LDA(At, 0, 0); PG8_STAGE(PG8_SA(1, 1), a1 + hstep, voffA);
            PG8_WAIT_V(8); PG8_WAIT_L(0); PG8_BAR; PG8_MMA(0, 0, At, B0); PG8_MMA(0, 1, At, B1); PG8_BAR; PG8_SCHED;
            PG8_LDA(At, 0, 1); PG8_STAGE(PG8_SB(0, 0), b2, voffB); PG8_STAGE(PG8_SB(0, 1), b2 + hstep, voffB); PG8_STAGE(PG8_SA(0, 0), a2, voffA);
            PG8_WAIT_V(8); PG8_WAIT_L(0); PG8_BAR; PG8_MMA(1, 0, At, B0); PG8_MMA(1, 1, At, B1); PG8_BAR; PG8_SCHED;
            PG8_LDB(B0, 1, 0); PG8_LDB(B1, 1, 1); PG8_SCHED; PG8_LDA(At, 1, 0); PG8_STAGE(PG8_SA(0, 1), a2 + hstep, voffA);
            PG8_WAIT_V(8); PG8_WAIT_L(0); PG8_BAR; PG8_MMA(0, 0, At, B0); PG8_MMA(0, 1, At, B1); PG8_BAR; PG8_SCHED;
            PG8_LDA(At, 1, 1); PG8_STAGE(PG8_SB(1, 0), b3, voffB); PG8_STAGE(PG8_SB(1, 1), b3 + hstep, voffB); PG8_STAGE(PG8_SA(1, 0), a3, voffA);
            PG8_WAIT_V(8); PG8_WAIT_L(0); PG8_BAR; PG8_MMA(1, 0, At, B0); PG8_MMA(1, 1, At, B1); PG8_BAR; PG8_SCHED;
            } else {
            PG8_LDB(B0, 0, 0); PG8_SCHED; PG8_LDA(At, 0, 0); PG8_STAGE(PG8_SA(1, 1), a1 + hstep, voffA);
            PG8_WAIT_L(8); PG8_BAR; PG8_WAIT_L(0); PG8_MMA(0, 0, At, B0); PG8_BAR; PG8_SCHED;
            PG8_LDB(B1, 0, 1); PG8_STAGE(PG8_SB(0, 0), b2, voffB);
            PG8_BAR; PG8_WAIT_L(0); PG8_MMA(0, 1, At, B1); PG8_BAR;
            PG8_LDA(At, 0, 1); PG8_STAGE(PG8_SA(0, 0), a2, voffA);
            PG8_BAR; PG8_WAIT_L(0); PG8_MMA(1, 0, At, B0); PG8_BAR; PG8_SCHED;
            PG8_STAGE(PG8_SB(0, 1), b2 + hstep, voffB);
            PG8_WAIT_V(6); PG8_BAR; PG8_MMA(1, 1, At, B1); PG8_BAR;
            PG8_LDB(B0, 1, 0); PG8_SCHED; PG8_LDA(At, 1, 0); PG8_STAGE(PG8_SA(0, 1), a2 + hstep, voffA);
            PG8_WAIT_L(8); PG8_BAR; PG8_WAIT_L(0); PG8_MMA(0, 0, At, B0); PG8_BAR; PG8_SCHED;
            PG8_LDB(B1, 1, 1); PG8_STAGE(PG8_SB(1, 0), b3, voffB);
            PG8_BAR; PG8_WAIT_L(0); PG8_MMA(0, 1, At, B1); PG8_BAR;
            PG8_LDA(At, 1, 1); PG8_STAGE(PG8_SA(1, 0), a3, voffA);
            PG8_BAR; PG8_WAIT_L(0); PG8_MMA(1, 0, At, B0); PG8_BAR; PG8_SCHED;
            PG8_STAGE(PG8_SB(1, 1), b3 + hstep, voffB);
            PG8_WAIT_V(6); PG8_BAR; PG8_MMA(1, 1, At, B1); PG8_BAR;
            }
        }
        if constexpr (ALIGN_EPI) { if (wr == 0) PG8_BAR; }
        if constexpr (!Epi::AFTER_DRAIN) { E(acc, cur, wr, wc, fr, fq); S.done(cur); }
        if (!has_next) break;
#pragma unroll
        for (int a = 0; a < 2; ++a)
#pragma unroll
            for (int b = 0; b < 2; ++b)
#pragma unroll
                for (int m = 0; m < 4; ++m)
#pragma unroll
                    for (int n = 0; n < 2; ++n) acc[a][b][m][n] = (f32x4){0.f, 0.f, 0.f, 0.f};
        cur = nxt; cA = nA; cB = nB; ++ui;
        if constexpr (ALIGN_EPI) { if (wr == 1) PG8_BAR; }
    }
    PG8_WAIT_V(0);
    if constexpr (!ALIGN_EPI) { if (wr == 0) PG8_BAR; }
    PG8_BAR;
    if constexpr (Epi::AFTER_DRAIN) { E.fused(acc, cur, wr, wc, fr, fq, lds, wid, lane); S.done(cur); }
#undef PG8_SA
#undef PG8_SB
#undef PG8_STAGE
#undef PG8_LDA
#undef PG8_LDB
#undef PG8_MMA
#undef PG8_WAIT_V
#undef PG8_WAIT_L
#undef PG8_BAR
#undef PG8_SCHED
}
}

#define ST4(ptr, V, O) do { u32x2 w_ = {cvtpk(V[(O) + 0], V[(O) + 1]), cvtpk(V[(O) + 2], V[(O) + 3])}; *(u32x2*)(ptr) = w_; } while (0)
#define PG8_FOREACH(acc, u, F) do {                                                                                   \
    _Pragma("unroll") for (int ai = 0; ai < 2; ++ai) _Pragma("unroll") for (int bj = 0; bj < 2; ++bj) _Pragma("unroll") for (int m = 0; m < 4; ++m) {   \
      const int row_ = (u).pm * 256 + ai * 128 + wr * 64 + m * 16 + fr, c0_ = (u).pn * 256 + bj * 128 + wc * 32 + 8 * fq;   \
      F(acc[ai][bj][m][0], acc[ai][bj][m][1], row_, c0_); SBAR(); } } while (0)

struct EpiG3 {
  static constexpr bool PERM = true, AFTER_DRAIN = false;
  const float* x; float* out; const float* bo;
  __device__ __forceinline__ void blk(const f32x4& a0, const f32x4& a1, int row, int c0) const {
    const f32x4 b0 = *(const f32x4*)(bo + c0), b1 = *(const f32x4*)(bo + c0 + 4);
    const f32x4 x0 = *(const f32x4*)(x + (long)row * DM + c0), x1 = *(const f32x4*)(x + (long)row * DM + c0 + 4);
    *(f32x4*)(out + (long)row * DM + c0) = a0 + b0 + ALPHA * x0;
    *(f32x4*)(out + (long)row * DM + c0 + 4) = a1 + b1 + ALPHA * x1;
  }
  __device__ __forceinline__ void operator()(const f32x4 (&acc)[2][2][4][2], const pg8::Unit& u, int wr, int wc, int fr, int fq) const {
#define G3F(A0, A1, R, C) blk(A0, A1, R, C)
    PG8_FOREACH(acc, u, G3F);
#undef G3F
  }
};
__device__ __forceinline__ void phase_gemm3_new(const Params& p, int g, char* lds, int vid) {
  unsigned char* ws = p.ws;
  EpiG3 E; E.x = p.x[g]; E.out = p.out + (size_t)g * TG * DM; E.bo = p.b_out;
  pg8::Gemm G; G.A = (const bf16_t*)(ws + OFF_XB); G.Bt = (const bf16_t*)(ws + OFF_WOUT); G.M = TG; G.N = 1024; G.K = DM;
  pg8::GroupOrder S; S.xg = vid & 7; S.jl = vid >> 3; S.npn = 4;
  pg8::gemm_phase<EpiG3, pg8::GroupOrder, false, true>((PG8_LAS unsigned char*)lds, G, S, E);
}

struct EpiG1n {
  static constexpr bool PERM = true, AFTER_DRAIN = false;
  bf16_t *U, *CGb, *Qb, *Kb, *Vb, *AGb, *MCb, *MAb; const f32x2* rope; const float* biasv; int seqmask;
  template <int KIND> __device__ __forceinline__ void blk(const f32x4& a0, const f32x4& a1, int row, int c0) const {
    const f32x4 b0 = *(const f32x4*)(biasv + c0), b1 = *(const f32x4*)(biasv + c0 + 4);
    float v[8] = {a0[0] + b0[0], a0[1] + b0[1], a0[2] + b0[2], a0[3] + b0[3], a1[0] + b1[0], a1[1] + b1[1], a1[2] + b1[2], a1[3] + b1[3]};
    if constexpr (KIND == 0 || KIND == 2 || KIND == 3) {
      float w[8];
#pragma unroll
      for (int j = 0; j < 8; ++j) w[j] = __shfl_xor(v[j], 16);
      const int par = (c0 >> 3) & 1, cg = c0 & ~15;
      if constexpr (KIND == 0) {
        if (par == 0) { float o[8];
#pragma unroll
          for (int j = 0; j < 8; ++j) o[j] = v[j] * sigmoidf_(w[j]);
          ST8(U + (long)row * 512 + (cg >> 1), o, 0); }
      } else {
        constexpr bool isq = (KIND == 2); const int j0 = cg - (isq ? 1536 : 2048), b = j0 >> 5, gq = b >> 1, sub = b & 1, d0 = 16 * sub + 8 * ((j0 >> 4) & 1);
        const int pos = row & seqmask;
        const f32x2* cs = rope + (long)pos * 32 + d0;
        const f32x4 c01 = *(const f32x4*)cs, c23 = *(const f32x4*)(cs + 2), c45 = *(const f32x4*)(cs + 4), c67 = *(const f32x4*)(cs + 6);
        const float cc[8] = {c01[0], c01[2], c23[0], c23[2], c45[0], c45[2], c67[0], c67[2]}, sn[8] = {c01[1], c01[3], c23[1], c23[3], c45[1], c45[3], c67[1], c67[3]};
        float o[8]; constexpr float sc = isq ? QSCALE : 1.f; const float sg = par ? 1.f : -1.f;
#pragma unroll
        for (int j = 0; j < 8; ++j) o[j] = (v[j] * cc[j] + sg * (w[j] * sn[j])) * sc;
        ST8((isq ? Qb : Kb) + (long)row * 512 + 64 * gq + d0 + 32 * par, o, 0);
      }
    } else if constexpr (KIND == 1 || KIND == 5) {
      float o[8];
#pragma unroll
      for (int j = 0; j < 8; ++j) o[j] = siluf_(v[j]);
      bf16_t* dp = (KIND == 1) ? (CGb + (long)row * 512 + (c0 - 1024)) : (AGb + (long)row * 512 + (c0 - 3072)); ST8(dp, o, 0);
    } else if constexpr (KIND == 4) {
      ST8(Vb + (long)row * 512 + (c0 - 2560), v, 0);
    } else {
      float o[8];
#pragma unroll
      for (int j = 0; j < 8; ++j) o[j] = sigmoidf_(v[j]);
      bf16_t* dp = (KIND == 6) ? (MCb + (long)row * 1024 + (c0 - 3584)) : (MAb + (long)row * 1024 + (c0 - 4608)); ST8(dp, o, 0);
    }
  }
  template <int KIND> __device__ __forceinline__ void all(const f32x4 (&acc)[2][2][4][2], const pg8::Unit& u, int wr, int wc, int fr, int fq) const {
#define G1F(A0, A1, R, C) blk<KIND>(A0, A1, R, C)
    PG8_FOREACH(acc, u, G1F);
#undef G1F
  }
  __device__ __forceinline__ void operator()(const f32x4 (&acc)[2][2][4][2], const pg8::Unit& u, int wr, int wc, int fr, int fq) const {
    const int pn = u.pn;
    if (pn < 4) all<0>(acc, u, wr, wc, fr, fq);
    else if (pn < 6) all<1>(acc, u, wr, wc, fr, fq);
    else if (pn < 8) all<2>(acc, u, wr, wc, fr, fq);
    else if (pn < 10) all<3>(acc, u, wr, wc, fr, fq);
    else if (pn < 12) all<4>(acc, u, wr, wc, fr, fq);
    else if (pn < 14) all<5>(acc, u, wr, wc, fr, fq);
    else if (pn < 18) all<6>(acc, u, wr, wc, fr, fq);
    else all<7>(acc, u, wr, wc, fr, fq);
  }
};
__device__ __forceinline__ void phase_gemm1_new(const Params& p, int g, char* lds, int vid) {
  unsigned char* ws = p.ws;
  EpiG1n E;
  E.biasv = (const float*)(ws + OFF_BIASV); E.rope = (const f32x2*)(ws + OFF_ROPE);
  E.U = (bf16_t*)(ws + OFF_U); E.CGb = (bf16_t*)(ws + OFF_CG); E.Qb = (bf16_t*)(ws + OFF_Q); E.Kb = (bf16_t*)(ws + OFF_K);
  E.Vb = (bf16_t*)(ws + OFF_V); E.AGb = (bf16_t*)(ws + OFF_AG); E.MCb = (bf16_t*)(ws + OFF_MC); E.MAb = (bf16_t*)(ws + OFF_MA);
  E.seqmask = (g == 0) ? 16383 : 8191;
  pg8::Gemm G; G.A = (g == 0) ? (const bf16_t*)(ws + OFF_XB) : (const bf16_t*)((unsigned char*)p.out + (size_t)TG * DM * 4); G.Bt = (const bf16_t*)(ws + OFF_WIN); G.M = TG; G.N = NV; G.K = DM;
  pg8::GroupOrder S; S.xg = vid & 7; S.jl = vid >> 3; S.npn = 20;
  pg8::gemm_phase<EpiG1n, pg8::GroupOrder, true, true>((PG8_LAS unsigned char*)lds, G, S, E);
  {
    const int tid = otid(), wid = tid >> 6, lane = tid & 63, wr = wid >> 2, wc = wid & 3, r32 = lane & 31, hi = lane >> 5;
    const int xg = vid & 7, jl = vid >> 3;
    G1Ptrs P; P.biasv = E.biasv; P.rope = E.rope; P.U = E.U; P.CGb = E.CGb; P.Qb = E.Qb; P.Kb = E.Kb; P.Vb = E.Vb; P.AGb = E.AGb; P.MCb = E.MCb; P.MAb = E.MAb; P.seqmask = E.seqmask;
    int pm = 8 * xg + (jl & 7); const int n0 = 20 * 256 + 128 * (jl >> 3);
    asm volatile("" : "+s"(pm));
    f32x16 acc1[4][1];
#pragma unroll
    for (int mi = 0; mi < 4; ++mi) acc1[mi][0] = f32x16{};
    gemm_loop<1>(G.A + (long)pm * 256 * DM, DM, G.Bt + (long)n0 * DM, DM, DM / 64, lds, acc1);
    const int row0 = pm * 256 + 128 * wr + r32, vc0 = n0 + 32 * wc + 16 * hi;
    g1_block<7>(acc1[0][0], P, row0, vc0, hi); SBAR();
    g1_block<7>(acc1[1][0], P, row0 + 32, vc0, hi); SBAR();
    g1_block<7>(acc1[2][0], P, row0 + 64, vc0, hi); SBAR();
    g1_block<7>(acc1[3][0], P, row0 + 96, vc0, hi); SBAR();
  }
}

__device__ __forceinline__ void phase_ln(const Params& p, int g) {
  float* out = p.out + (size_t)g * TG * DM;
  const int tid = otid(), wid = tid >> 6, lane = tid & 63;
  for (int row = blockIdx.x * 8 + wid; row < TG; row += gridDim.x * 8) {
    float* rp = out + (long)row * DM;
    f32x4 v[4]; float s = 0.f;
#pragma unroll
    for (int i = 0; i < 4; ++i) { v[i] = *(const f32x4*)(rp + i * 256 + lane * 4); s += (v[i][0] + v[i][1]) + (v[i][2] + v[i][3]); }
#pragma unroll
    for (int m = 1; m < 64; m <<= 1) s += __shfl_xor(s, m);
    const float mean = s * (1.f / 1024.f); float q = 0.f;
#pragma unroll
    for (int i = 0; i < 4; ++i) { v[i] = v[i] - mean; q += (v[i][0] * v[i][0] + v[i][1] * v[i][1]) + (v[i][2] * v[i][2] + v[i][3] * v[i][3]); }
#pragma unroll
    for (int m = 1; m < 64; m <<= 1) q += __shfl_xor(q, m);
    const float rstd = rsqrtf(q * (1.f / 1024.f) + LN_EPS);
#pragma unroll
    for (int i = 0; i < 4; ++i) { f32x4 gg = *(const f32x4*)(p.ln_g + i * 256 + lane * 4), bb = *(const f32x4*)(p.ln_b + i * 256 + lane * 4);
      *(f32x4*)(rp + i * 256 + lane * 4) = v[i] * rstd * gg + bb; }
  }
}

__device__ __forceinline__ void phase_prologue(const Params& p, char* lds) {
  unsigned char* ws = p.ws;
  int bi = 0;
  for (int t = blockIdx.x; t < 1920; t += gridDim.x, ++bi) {
    if (t < 1408) transpose_tile(p, bi, p.w_in, NV, 1024, (bf16_t*)(ws + OFF_WIN), true, t >> 4, t & 15, lds);
    else if (t < 1536) transpose_tile(p, bi, p.w_cp, 1024, 512, (bf16_t*)(ws + OFF_WCP), false, (t - 1408) >> 3, (t - 1408) & 7, lds);
    else if (t < 1664) transpose_tile(p, bi, p.w_ao, 1024, 512, (bf16_t*)(ws + OFF_WAO), false, (t - 1536) >> 3, (t - 1536) & 7, lds);
    else transpose_tile(p, bi, p.w_out, 1024, 1024, (bf16_t*)(ws + OFF_WOUT), false, (t - 1664) >> 4, (t - 1664) & 15, lds);
  }
  for (; bi < 8; ++bi) cvt_batch(p, bi);
  const long gt = (long)blockIdx.x * NTHR + threadIdx.x, gn = (long)gridDim.x * NTHR;
  float* biasv = (float*)(ws + OFF_BIASV);
  for (long i = gt; i < NV; i += gn) biasv[i] = p.b_in[win_actual((int)i)];
  f32x2* rope = (f32x2*)(ws + OFF_ROPE);
  for (long i = gt; i < 16384L * 32; i += gn) { const int pos = (int)(i >> 5), f = (int)(i & 31); const double a = (double)pos * p.inv_freq_pi[f];
    rope[i] = f32x2{(float)cospi(a), (float)sinpi(a)}; }
  if (gt == 0) { float s1 = 0.f, s2 = 0.f; for (int i = 0; i < 64; ++i) { s1 += p.lq1[i] * p.lk1[i]; s2 += p.lq2[i] * p.lk2[i]; }
    *(float*)(ws + OFF_MISC) = expf(s1) - expf(s2) + LAM_INIT; }
}

__device__ __forceinline__ void panel_arrive(unsigned* cnt, bool same_xcd) {
  asm volatile("s_waitcnt vmcnt(0) lgkmcnt(0)" ::: "memory"); __syncthreads();
  if (threadIdx.x == 0) { if (!same_xcd) { __builtin_amdgcn_fence(__ATOMIC_RELEASE, "agent"); asm volatile("s_waitcnt vmcnt(0)" ::: "memory"); }
    __hip_atomic_fetch_add(cnt, 1u, __ATOMIC_RELAXED, __HIP_MEMORY_SCOPE_AGENT); }
}
__device__ __forceinline__ void panel_wait(unsigned* cnt, unsigned want) {
  if (threadIdx.x == 0) { while (__hip_atomic_load(cnt, __ATOMIC_RELAXED, __HIP_MEMORY_SCOPE_AGENT) < want) __builtin_amdgcn_s_sleep(1);
    __builtin_amdgcn_fence(__ATOMIC_ACQUIRE, "agent"); asm volatile("s_waitcnt vmcnt(0)" ::: "memory"); }
  __syncthreads();
}
__device__ __forceinline__ void phase_ln_panel(const Params& p, int g, int vid) {
  float* out = p.out + (size_t)g * TG * DM;
  const int tid = otid(), wid = tid >> 6, lane = tid & 63;
  const int xg = vid & 7, jl = vid >> 3, row0 = (8 * xg + (jl & 7)) * 256 + (jl >> 3) * 64 + wid * 8;
#pragma unroll 1
  for (int i = 0; i < 8; ++i) {
    float* rp = out + (long)(row0 + i) * DM;
    f32x4 v[4]; float sm = 0.f;
#pragma unroll
    for (int k = 0; k < 4; ++k) { v[k] = *(const f32x4*)(rp + k * 256 + lane * 4); sm += (v[k][0] + v[k][1]) + (v[k][2] + v[k][3]); }
#pragma unroll
    for (int m = 1; m < 64; m <<= 1) sm += __shfl_xor(sm, m);
    const float mean = sm * (1.f / 1024.f); float q = 0.f;
#pragma unroll
    for (int k = 0; k < 4; ++k) { v[k] = v[k] - mean; q += (v[k][0] * v[k][0] + v[k][1] * v[k][1]) + (v[k][2] * v[k][2] + v[k][3] * v[k][3]); }
#pragma unroll
    for (int m = 1; m < 64; m <<= 1) q += __shfl_xor(q, m);
    const float rstd = rsqrtf(q * (1.f / 1024.f) + LN_EPS);
#pragma unroll
    for (int k = 0; k < 4; ++k) { f32x4 gg = *(const f32x4*)(p.ln_g + k * 256 + lane * 4), bb = *(const f32x4*)(p.ln_b + k * 256 + lane * 4);
      *(f32x4*)(rp + k * 256 + lane * 4) = v[k] * rstd * gg + bb; }
  }
}

#define LAS __attribute__((address_space(3)))
#define XB_TMO      128
#define XB_XCNT(j)  (256  + 64 * (j))
#define XB_XSUB(j)  (1280 + 64 * (j))
#define XB_XGEN(j)  (2304 + 64 * (j))
#define XB_TOP      3328
#define XB_TOPGEN   3392
#define XCD_BAR_WORDS 3456
#define XB_SPIN_CAP (1u << 18)

__device__ __forceinline__ unsigned xb_ld(unsigned* p)              { return __hip_atomic_load(p, __ATOMIC_RELAXED, __HIP_MEMORY_SCOPE_AGENT); }
__device__ __forceinline__ unsigned xb_add(unsigned* p, unsigned v) { return __hip_atomic_fetch_add(p, v, __ATOMIC_RELAXED, __HIP_MEMORY_SCOPE_AGENT); }
__device__ __forceinline__ unsigned xb_xcc_id() { return (unsigned)__builtin_amdgcn_s_getreg((3 << 11) | 20) & 0xFu; }
#define XB_SPIN(cond, bar) do { unsigned _sp = 0; while (cond) { __builtin_amdgcn_s_sleep(1); \
    if ((++_sp & 255u) == 0u) { if (xb_ld(&(bar)[XB_TMO])) break; if (_sp > XB_SPIN_CAP) { atomicAdd(&(bar)[XB_TMO], 1u); break; } } } } while (0)

struct XcdBarrier {
    unsigned* bar; unsigned x;
    volatile LAS unsigned* st;
};

__device__ __forceinline__ XcdBarrier xcd_barrier_post(unsigned* bar, volatile LAS unsigned* st) {
    XcdBarrier b; b.bar = bar; b.x = xb_xcc_id(); b.st = st;
    if (threadIdx.x == 0) (void)xb_add(&bar[XB_XCNT(b.x)], 1u);
    return b;
}
__device__ __forceinline__ void xcd_barrier_complete(unsigned* bar, unsigned x, unsigned& nloc, unsigned& nx) {
    const unsigned G = gridDim.x * gridDim.y * gridDim.z;
    unsigned sum, cnt, mine, sp = 0u;
    for (;;) {
        sum = 0u; cnt = 0u; mine = 0u;
#pragma unroll
        for (unsigned j = 0; j < 16; ++j) { const unsigned c = xb_ld(&bar[XB_XCNT(j)]); sum += c; cnt += (c > 0u) ? 1u : 0u; mine = (j == x) ? c : mine; }
        if (sum == G) break;
        __builtin_amdgcn_s_sleep(1);
        if ((++sp & 255u) == 0u) { if (xb_ld(&bar[XB_TMO])) break; if (sp > XB_SPIN_CAP) { atomicAdd(&bar[XB_TMO], 1u); break; } }
    }
    nloc = mine > 0u ? mine : 1u; nx = cnt > 0u ? cnt : 1u;
}

__device__ __forceinline__ void xcd_barrier(const XcdBarrier& b) {
    asm volatile("s_waitcnt vmcnt(0)" ::: "memory");
    __syncthreads();
    if (threadIdx.x == 0) {
        unsigned* bar = b.bar;
        __builtin_amdgcn_s_waitcnt(0);
        unsigned nloc = b.st[0], nx = b.st[1];
        if (nloc == 0u) { xcd_barrier_complete(bar, b.x, nloc, nx); b.st[0] = nloc; b.st[1] = nx; }
        const unsigned old = xb_add(&bar[XB_XSUB(b.x)], 1u);
        const unsigned gen = old / nloc;
        if (old + 1u == (gen + 1u) * nloc) {
            __builtin_amdgcn_fence(__ATOMIC_RELEASE, "agent");
            asm volatile("s_waitcnt vmcnt(0)" ::: "memory");
            const unsigned og = xb_add(&bar[XB_TOP], 1u);
            const unsigned tg = og / nx;
            if (og + 1u == (tg + 1u) * nx) xb_add(&bar[XB_TOPGEN], 1u);
            else XB_SPIN(xb_ld(&bar[XB_TOPGEN]) == tg, bar);
            __builtin_amdgcn_fence(__ATOMIC_ACQUIRE, "agent");
            xb_add(&bar[XB_XGEN(b.x)], 1u);
            asm volatile("s_waitcnt vmcnt(0)" ::: "memory");
        } else {
            XB_SPIN(xb_ld(&bar[XB_XGEN(b.x)]) == gen, bar);
            __builtin_amdgcn_fence(__ATOMIC_ACQUIRE, "agent");
            asm volatile("s_waitcnt vmcnt(0)" ::: "memory");
        }
    }
    __syncthreads();
}

__global__ void __launch_bounds__(NTHR, 2) fwd_kernel(Params p) {
  extern __shared__ __attribute__((aligned(16))) char lds[];
#if MULTI_LAUNCH
#define GSYNC() do { } while (0)
#else
  cg::grid_group grid = cg::this_grid();
  unsigned* bar = (unsigned*)(p.ws + OFF_BAR);
  volatile LAS unsigned* xst = (volatile LAS unsigned*)(lds + LDS_BYTES - 32);
  if (threadIdx.x == 0) { xst[0] = 0u; xst[1] = 0u; }
  __syncthreads();
  const XcdBarrier xb = xcd_barrier_post((unsigned*)(p.ws + OFF_XBAR), xst);
#define GSYNC() xcd_barrier(xb)
#endif
  int vid = blockIdx.x; bool same_xcd = false;
#if !MULTI_LAUNCH
  unsigned my_xcc = 0, my_rank = 0;
  if (threadIdx.x == 0) { my_xcc = (unsigned)__builtin_amdgcn_s_getreg((3 << 11) | 20) & 7u; my_rank = __hip_atomic_fetch_add(bar + 8 + my_xcc, 1u, __ATOMIC_RELAXED, __HIP_MEMORY_SCOPE_AGENT); }
#endif
  int ph = 0;
#define PHASE(body) do { if (ph >= p.ph_lo && ph < p.ph_hi) { body; if (ph + 1 < p.ph_hi) GSYNC(); } ++ph; } while (0)
  PHASE(phase_prologue(p, lds));
#if !MULTI_LAUNCH
  {
    int* vsh = (int*)(lds + LDS_BYTES - 16);
    if (threadIdx.x == 0) { bool ok = true; for (int i = 0; i < 8; ++i) ok = ok && (__hip_atomic_load(bar + 8 + i, __ATOMIC_RELAXED, __HIP_MEMORY_SCOPE_AGENT) == 32u);
      const bool use = ok && my_rank < 32u; vsh[0] = use ? (int)(my_xcc + 8u * my_rank) : (int)blockIdx.x; vsh[1] = ok ? 1 : 0; }
    __syncthreads(); vid = __builtin_amdgcn_readfirstlane(vsh[0]); same_xcd = __builtin_amdgcn_readfirstlane(vsh[1]) != 0; __syncthreads();
  }
#endif
  for (int g = 0; g < 2; ++g) {
    PHASE(phase_gemm1_new(p, g, lds, vid));
    PHASE({ phase_conv(p, g, lds); phase_attn(p, g, lds, vid); });
    PHASE({ unsigned* pw = (unsigned*)(p.ws + OFF_BAR); const int pm_ = 8 * (vid & 7) + ((vid >> 3) & 7);
            phase_gemm2(p, lds, vid); panel_arrive(pw + 64 + 64 * g + pm_, same_xcd); panel_wait(pw + 64 + 64 * g + pm_, 4u);
            phase_gemm3_new(p, g, lds, vid); panel_arrive(pw + 192 + 64 * g + pm_, same_xcd); panel_wait(pw + 192 + 64 * g + pm_, 4u);
            phase_ln_panel(p, g, vid); });
  }
}
constexpr int N_PHASES = 7;

extern "C" void kernel_launch(void* const* d_in, const int* in_sizes, int n_in, void* d_out, int out_size, void* d_ws, size_t ws_size, hipStream_t stream) {
  static int grid = 0;
  if (grid == 0) {
    if (n_in != 20 || ws_size < WS_END || out_size != 2 * TG * DM) { fprintf(stderr, "kernel_launch: unexpected shapes n_in %d ws %zu out %d\n", n_in, ws_size, out_size); grid = -1; return; }
    int dev = 0, cus = 0, per_cu = 0;
    hipGetDevice(&dev); hipDeviceGetAttribute(&cus, hipDeviceAttributeMultiprocessorCount, dev);
    if (hipFuncSetAttribute((const void*)fwd_kernel, hipFuncAttributeMaxDynamicSharedMemorySize, LDS_BYTES) != hipSuccess) { fprintf(stderr, "kernel_launch: LDS attribute failed\n"); grid = -1; return; }
    hipOccupancyMaxActiveBlocksPerMultiprocessor(&per_cu, (const void*)fwd_kernel, NTHR, LDS_BYTES);
    if (per_cu < 1) { fprintf(stderr, "kernel_launch: occupancy query says %d\n", per_cu); per_cu = 1; }
    grid = cus;
    if (grid != 256) { fprintf(stderr, "kernel_launch: built for 256 CUs, found %d\n", grid); grid = 256; }
  }
  if (grid < 0) return;
  Params p{};
  p.x[0] = (const float*)d_in[0]; p.x[1] = (const float*)d_in[1];
  p.w_in = (const float*)d_in[2]; p.b_in = (const float*)d_in[3]; p.conv_dw = (const float*)d_in[4]; p.conv_dw_b = (const float*)d_in[5];
  p.conv_ln_g = (const float*)d_in[6]; p.conv_ln_b = (const float*)d_in[7]; p.w_cp = (const float*)d_in[8]; p.b_cp = (const float*)d_in[9];
  p.lq1 = (const float*)d_in[10]; p.lk1 = (const float*)d_in[11]; p.lq2 = (const float*)d_in[12]; p.lk2 = (const float*)d_in[13];
  p.subln_g = (const float*)d_in[14]; p.w_ao = (const float*)d_in[15]; p.w_out = (const float*)d_in[16]; p.b_out = (const float*)d_in[17];
  p.ln_g = (const float*)d_in[18]; p.ln_b = (const float*)d_in[19];
  p.out = (float*)d_out; p.ws = (unsigned char*)d_ws;
  for (int i = 0; i < 32; ++i) p.inv_freq_pi[i] = pow(10000.0, -(double)i / 32.0) / 3.14159265358979323846;
#if MULTI_LAUNCH
  for (int ph = 0; ph < N_PHASES; ++ph) { p.ph_lo = ph; p.ph_hi = ph + 1; hipLaunchKernelGGL(fwd_kernel, dim3(grid), dim3(NTHR), LDS_BYTES, stream, p); }
#else
  p.ph_lo = 0; p.ph_hi = N_PHASES;
  if (hipMemsetAsync((unsigned char*)d_ws + OFF_BAR, 0, 4096 + 16384, stream) != hipSuccess) { fprintf(stderr, "kernel_launch: memset failed\n"); return; }
  void* args[] = {&p};
  hipError_t e = hipLaunchCooperativeKernel((const void*)fwd_kernel, dim3(grid), dim3(NTHR), args, LDS_BYTES, stream);
  if (e != hipSuccess) fprintf(stderr, "kernel_launch: cooperative launch failed: %s\n", hipGetErrorString(e));
#endif
}
```

```cpp
#include <hip/hip_runtime.h>
#include <hip/hip_cooperative_groups.h>
#include <cstdint>
#include <cstdio>
#include <cmath>
namespace cg = cooperative_groups;

#ifndef MULTI_LAUNCH
#define MULTI_LAUNCH 0
#endif

typedef unsigned short bf16_t;
typedef short bf16x8 __attribute__((ext_vector_type(8)));
typedef short s16x4 __attribute__((ext_vector_type(4)));
typedef float f32x16 __attribute__((ext_vector_type(16)));
typedef float f32x4 __attribute__((ext_vector_type(4)));
typedef float f32x2 __attribute__((ext_vector_type(2)));
typedef unsigned u32x4 __attribute__((ext_vector_type(4)));
typedef unsigned u32x2 __attribute__((ext_vector_type(2)));

constexpr int DM = 1024, TG = 16384, NV = 5632, NTHR = 512;
constexpr float LN_EPS = 1e-5f;
constexpr float ALPHA = 1.189207115002721f;
constexpr float LAM_INIT = 0.2f;
constexpr float QSCALE = 0.125f * 1.4426950408889634f;

constexpr size_t OFF_WIN = 0;
constexpr size_t OFF_WCP = OFF_WIN + (size_t)NV * 1024 * 2;
constexpr size_t OFF_WAO = OFF_WCP + (size_t)1024 * 512 * 2;
constexpr size_t OFF_WOUT = OFF_WAO + (size_t)1024 * 512 * 2;
constexpr size_t OFF_BIASV = OFF_WOUT + (size_t)1024 * 1024 * 2;
constexpr size_t OFF_ROPE = OFF_BIASV + 32768;
constexpr size_t OFF_MISC = OFF_ROPE + (size_t)16384 * 32 * 8;
constexpr size_t OFF_XB = OFF_MISC + 256;
constexpr size_t OFF_U = OFF_XB + (size_t)TG * 1024 * 2;
constexpr size_t OFF_CG = OFF_U + (size_t)TG * 512 * 2;
constexpr size_t OFF_Q = OFF_CG + (size_t)TG * 512 * 2;
constexpr size_t OFF_K = OFF_Q + (size_t)TG * 512 * 2;
constexpr size_t OFF_V = OFF_K + (size_t)TG * 512 * 2;
constexpr size_t OFF_AG = OFF_V + (size_t)TG * 512 * 2;
constexpr size_t OFF_MC = OFF_AG + (size_t)TG * 512 * 2;
constexpr size_t OFF_MA = OFF_MC + (size_t)TG * 1024 * 2;
constexpr size_t OFF_U2 = OFF_MA + (size_t)TG * 1024 * 2;
constexpr size_t OFF_O2 = OFF_U2 + (size_t)TG * 512 * 2;
constexpr size_t OFF_BAR = OFF_O2 + (size_t)TG * 512 * 2;
constexpr size_t OFF_XBAR = OFF_BAR + 4096;
constexpr size_t WS_END = OFF_XBAR + 16384;
static_assert(WS_END <= (size_t)256 * 1024 * 1024, "workspace over 256 MiB");
constexpr int LDS_BYTES = 131072 + 4096;

struct Params {
  const float* x[2];
  const float *w_in, *b_in, *conv_dw, *conv_dw_b, *conv_ln_g, *conv_ln_b, *w_cp, *b_cp, *lq1, *lk1, *lq2, *lk2, *subln_g, *w_ao, *w_out, *b_out, *ln_g, *ln_b;
  float* out;
  unsigned char* ws;
  double inv_freq_pi[32];
  int ph_lo, ph_hi;
};

__device__ __forceinline__ unsigned cvtpk(float lo, float hi) {
  unsigned r; asm volatile("v_cvt_pk_bf16_f32 %0, %1, %2" : "=v"(r) : "v"(lo), "v"(hi)); return r;
}
__device__ __forceinline__ float bf2f(unsigned short b) { return __uint_as_float(((unsigned)b) << 16); }
__device__ __forceinline__ float bflo(unsigned w) { return __uint_as_float(w << 16); }
__device__ __forceinline__ float bfhi(unsigned w) { return __uint_as_float(w & 0xffff0000u); }
__device__ __forceinline__ float sigmoidf_(float x) { return __builtin_amdgcn_rcpf(1.f + __expf(-x)); }
__device__ __forceinline__ float siluf_(float x) { return x * sigmoidf_(x); }
__device__ __forceinline__ int crow(int r, int hi) { return (r & 3) + 8 * (r >> 2) + 4 * hi; }
#define SBAR() __builtin_amdgcn_sched_barrier(0)
__device__ __forceinline__ int otid() { int t = threadIdx.x; asm volatile("" : "+v"(t)); return t; }

__device__ __forceinline__ int win_actual(int v) {
  if (v < 1024) { int b = v >> 5, h = (v >> 4) & 1, r = v & 15; int ch = 16 * b + 8 * h + (r & 7); return (r < 8) ? ch : 512 + ch; }
  if (v < 1536) return v;
  if (v < 2560) { int base = (v < 2048) ? 1536 : 2048; int j = v - base; int b = j >> 5, h = (j >> 4) & 1, r = j & 15; int g = b >> 1, sub = b & 1;
    int d = 16 * sub + 8 * h + (r & 7); return base + 64 * g + d + ((r >= 8) ? 32 : 0); }
  return v;
}

__device__ __forceinline__ void cvt_batch(const Params& p, int bi) {
  const float* __restrict__ src = p.x[bi >> 2];
  bf16_t* __restrict__ dst = (bi < 4) ? (bf16_t*)(p.ws + OFF_XB) : (bf16_t*)((unsigned char*)p.out + (size_t)TG * DM * 4);
  const long gn = (long)gridDim.x * NTHR, i = (long)blockIdx.x * NTHR + threadIdx.x + (long)(bi & 3) * 4 * gn;
  f32x4 a[4], b[4];
#pragma unroll
  for (int u = 0; u < 4; ++u) { a[u] = __builtin_nontemporal_load((const f32x4*)(src + (i + u * gn) * 8)); b[u] = __builtin_nontemporal_load((const f32x4*)(src + (i + u * gn) * 8 + 4)); }
#pragma unroll
  for (int u = 0; u < 4; ++u) { u32x4 w = {cvtpk(a[u][0], a[u][1]), cvtpk(a[u][2], a[u][3]), cvtpk(b[u][0], b[u][1]), cvtpk(b[u][2], b[u][3])};
    *(u32x4*)(dst + (i + u * gn) * 8) = w; }
}
__device__ __forceinline__ void transpose_tile(const Params& p, int bi, const float* __restrict__ src, int NS, int K, bf16_t* __restrict__ dst, bool mapped, int vt, int kt, char* lds) {
  float* tl = (float*)lds;
  const int tid = threadIdx.x;
  float r[8];
  const int j = tid & 63, v = vt * 64 + j, col = mapped ? win_actual(v) : v;
#pragma unroll
  for (int i = 0; i < 8; ++i) { const int kk = (tid >> 6) + 8 * i; r[i] = src[(long)(kt * 64 + kk) * NS + col]; }
  cvt_batch(p, bi);
  __syncthreads();
#pragma unroll
  for (int i = 0; i < 8; ++i) { const int kk = (tid >> 6) + 8 * i; tl[j * 65 + kk] = r[i]; }
  __syncthreads();
  { const int jj = tid >> 3, kc = (tid & 7) * 8; const float* q = tl + jj * 65 + kc;
    u32x4 w = {cvtpk(q[0], q[1]), cvtpk(q[2], q[3]), cvtpk(q[4], q[5]), cvtpk(q[6], q[7])};
    *(u32x4*)(dst + (long)(vt * 64 + jj) * K + kt * 64 + kc) = w; }
}

__device__ __forceinline__ int vperm(int p) { return 16 * ((p >> 2) & 1) + (p & 3) + 4 * (p >> 3); }
template <int NI>
__device__ __forceinline__ void gemm_loop(const bf16_t* __restrict__ A, int lda, const bf16_t* __restrict__ B, int ldb, int KT, char* lds, f32x16 (&acc)[4][NI]) {
  constexpr int A_BYTES = 256 * 128, B_BYTES = 128 * NI * 128, STAGE = A_BYTES + B_BYTES;
  const int tid = otid(), wid = tid >> 6, lane = tid & 63, wr = wid >> 2, wc = wid & 3, r32 = lane & 31, hi = lane >> 5;
  const int wbase_ = __builtin_amdgcn_readfirstlane(wid) * 64;
  const bf16_t* ga[4]; const bf16_t* gb[2 * NI];
#pragma unroll
  for (int i = 0; i < 4; ++i) { int q = i * NTHR + tid, R = q >> 3, pc = q & 7, c = pc ^ ((R >> 1) & 7); ga[i] = A + (long)R * lda + c * 8; }
#pragma unroll
  for (int i = 0; i < 2 * NI; ++i) { int q = i * NTHR + tid, R = q >> 3, pc = q & 7, c = pc ^ ((R >> 1) & 7); int Rg = (R & ~31) + vperm(R & 31); gb[i] = B + (long)Rg * ldb + c * 8; }
  const int sw = (r32 >> 1) & 7;
  int xo[4];
#pragma unroll
  for (int ks = 0; ks < 4; ++ks) xo[ks] = r32 * 128 + (((2 * ks + hi) ^ sw) << 4);
  const int a_base = (128 * wr) * 128, b_base = A_BYTES + (32 * NI * wc) * 128;
#define GL_A(sb_, i, kt) __builtin_amdgcn_global_load_lds((const unsigned*)(ga[i] + (kt) * 64), (unsigned*)((sb_) + ((i) * NTHR + wbase_) * 16), 16, 0, 0)
#define GL_B(sb_, i, kt) __builtin_amdgcn_global_load_lds((const unsigned*)(gb[i] + (kt) * 64), (unsigned*)((sb_) + A_BYTES + ((i) * NTHR + wbase_) * 16), 16, 0, 0)
  {
#pragma unroll
    for (int i = 0; i < 4; ++i) GL_A(lds, i, 0);
#pragma unroll
    for (int i = 0; i < 2 * NI; ++i) GL_B(lds, i, 0);
  }
#pragma unroll 1
  for (int kt = 0; kt < KT; ++kt) {
    asm volatile("s_waitcnt vmcnt(0)" ::: "memory");
    __syncthreads();
    const bool more = kt + 1 < KT;
    char* sn = lds + ((kt + 1) & 1) * STAGE;
    const char* sb = lds + (kt & 1) * STAGE;
    bf16x8 af[2][4], bfr[2][NI];
#define FRAG_RD(S, ks) do { _Pragma("unroll") for (int ni = 0; ni < NI; ++ni) bfr[S][ni] = *(const bf16x8*)(sb + b_base + ni * 4096 + xo[ks]);   \
                            _Pragma("unroll") for (int mi = 0; mi < 4; ++mi) af[S][mi] = *(const bf16x8*)(sb + a_base + mi * 4096 + xo[ks]); } while (0)
    FRAG_RD(0, 0);
#pragma unroll
    for (int ks = 0; ks < 4; ++ks) {
      const int cs = ks & 1;
      if (ks < 3) { if (cs == 0) FRAG_RD(1, ks + 1); else FRAG_RD(0, ks + 1); }
      SBAR();
#pragma unroll
      for (int mi = 0; mi < 2; ++mi)
#pragma unroll
        for (int ni = 0; ni < NI; ++ni) acc[mi][ni] = __builtin_amdgcn_mfma_f32_32x32x16_bf16(bfr[cs][ni], af[cs][mi], acc[mi][ni], 0, 0, 0);
      SBAR();
      if (more) { GL_A(sn, ks, kt + 1); if (NI == 2) { GL_B(sn, ks, kt + 1); } else if (ks < 2) { GL_B(sn, ks, kt + 1); } }
      SBAR();
#pragma unroll
      for (int mi = 2; mi < 4; ++mi)
#pragma unroll
        for (int ni = 0; ni < NI; ++ni) acc[mi][ni] = __builtin_amdgcn_mfma_f32_32x32x16_bf16(bfr[cs][ni], af[cs][mi], acc[mi][ni], 0, 0, 0);
    }
#undef FRAG_RD
  }
#undef GL_A
#undef GL_B
}

#define ST8(ptr, V, O) do { u32x4 w_ = {cvtpk(V[(O) + 0], V[(O) + 1]), cvtpk(V[(O) + 2], V[(O) + 3]), cvtpk(V[(O) + 4], V[(O) + 5]), cvtpk(V[(O) + 6], V[(O) + 7])}; *(u32x4*)(ptr) = w_; } while (0)

struct G1Ptrs { bf16_t *U, *CGb, *Qb, *Kb, *Vb, *AGb, *MCb, *MAb; const f32x2* rope; const float* biasv; int seqmask; };
template <int KIND>
__device__ __forceinline__ void g1_block(const f32x16& a, const G1Ptrs& P, int row, int vc0, int hi) {
  float v[16];
#pragma unroll
  for (int j = 0; j < 4; ++j) { f32x4 b4 = *(const f32x4*)(P.biasv + vc0 + 4 * j); v[4 * j] = a[4 * j] + b4[0]; v[4 * j + 1] = a[4 * j + 1] + b4[1]; v[4 * j + 2] = a[4 * j + 2] + b4[2]; v[4 * j + 3] = a[4 * j + 3] + b4[3]; }
  if constexpr (KIND == 0) {
    float o[8];
#pragma unroll
    for (int j = 0; j < 8; ++j) o[j] = v[j] * sigmoidf_(v[8 + j]);
    ST8(P.U + (long)row * 512 + (vc0 >> 1), o, 0);
  } else if constexpr (KIND == 1 || KIND == 5) {
    float o[16];
#pragma unroll
    for (int j = 0; j < 16; ++j) o[j] = siluf_(v[j]);
    bf16_t* d = (KIND == 1) ? (P.CGb + (long)row * 512 + (vc0 - 1024)) : (P.AGb + (long)row * 512 + (vc0 - 3072)); ST8(d, o, 0); ST8(d + 8, o, 8);
  } else if constexpr (KIND == 2 || KIND == 3) {
    constexpr bool isq = (KIND == 2); const int j0 = vc0 - (isq ? 1536 : 2048);
    const int b = j0 >> 5, gq = b >> 1, sub = b & 1, d0 = 16 * sub + 8 * hi;
    const int pos = row & P.seqmask;
    const f32x2* cs = P.rope + (long)pos * 32 + d0;
    float o1[8], o2[8]; constexpr float sc = isq ? QSCALE : 1.f;
#pragma unroll
    for (int j = 0; j < 4; ++j) { f32x4 c2 = *(const f32x4*)(cs + 2 * j);
      o1[2 * j] = (v[2 * j] * c2[0] - v[8 + 2 * j] * c2[1]) * sc; o2[2 * j] = (v[8 + 2 * j] * c2[0] + v[2 * j] * c2[1]) * sc;
      o1[2 * j + 1] = (v[2 * j + 1] * c2[2] - v[9 + 2 * j] * c2[3]) * sc; o2[2 * j + 1] = (v[9 + 2 * j] * c2[2] + v[2 * j + 1] * c2[3]) * sc; }
    bf16_t* d = (isq ? P.Qb : P.Kb) + (long)row * 512 + 64 * gq + d0; ST8(d, o1, 0); ST8(d + 32, o2, 0);
  } else if constexpr (KIND == 4) {
    bf16_t* d = P.Vb + (long)row * 512 + (vc0 - 2560); ST8(d, v, 0); ST8(d + 8, v, 8);
  } else {
    float o[16];
#pragma unroll
    for (int j = 0; j < 16; ++j) o[j] = sigmoidf_(v[j]);
    bf16_t* d = (KIND == 6) ? (P.MCb + (long)row * 1024 + (vc0 - 3584)) : (P.MAb + (long)row * 1024 + (vc0 - 4608)); ST8(d, o, 0); ST8(d + 8, o, 8);
  }
}
template <int KIND>
__device__ __forceinline__ void g1_epi(const f32x16 (&acc)[4][2], const G1Ptrs& P, int row0, int vcb, int hi) {
#define G1B(mi, ni) g1_block<KIND>(acc[mi][ni], P, row0 + 32 * (mi), vcb + 32 * (ni), hi); SBAR();
  G1B(0, 0) G1B(1, 0) G1B(2, 0) G1B(3, 0) G1B(0, 1) G1B(1, 1) G1B(2, 1) G1B(3, 1)
#undef G1B
}
__device__ __forceinline__ void phase_gemm1(const Params& p, int g, char* lds, int vid) {
  unsigned char* ws = p.ws;
  const bf16_t* Xb = (g == 0) ? (const bf16_t*)(ws + OFF_XB) : (const bf16_t*)((unsigned char*)p.out + (size_t)TG * DM * 4);
  const bf16_t* W = (const bf16_t*)(ws + OFF_WIN);
  G1Ptrs P;
  P.biasv = (const float*)(ws + OFF_BIASV); P.rope = (const f32x2*)(ws + OFF_ROPE);
  P.U = (bf16_t*)(ws + OFF_U); P.CGb = (bf16_t*)(ws + OFF_CG); P.Qb = (bf16_t*)(ws + OFF_Q); P.Kb = (bf16_t*)(ws + OFF_K);
  P.Vb = (bf16_t*)(ws + OFF_V); P.AGb = (bf16_t*)(ws + OFF_AG); P.MCb = (bf16_t*)(ws + OFF_MC); P.MAb = (bf16_t*)(ws + OFF_MA);
  P.seqmask = (g == 0) ? 16383 : 8191;
  const int tid = otid(), wid = tid >> 6, lane = tid & 63, wr = wid >> 2, wc = wid & 3, r32 = lane & 31, hi = lane >> 5;
  const int xg = vid & 7, jl = vid >> 3;
  for (int rnd = 0; rnd < 5; ++rnd) {
    int pm = 8 * xg + (jl & 7); const int pn = rnd * 4 + (jl >> 3);
    asm volatile("" : "+s"(pm));
    f32x16 acc[4][2];
#pragma unroll
    for (int mi = 0; mi < 4; ++mi)
#pragma unroll
      for (int ni = 0; ni < 2; ++ni) acc[mi][ni] = f32x16{};
    gemm_loop<2>(Xb + (long)pm * 256 * DM, DM, W + (long)pn * 256 * DM, DM, DM / 64, lds, acc);
    const int row0 = pm * 256 + 128 * wr + r32, vcb = pn * 256 + 64 * wc + 16 * hi;
    if (pn < 4) g1_epi<0>(acc, P, row0, vcb, hi);
    else if (pn < 6) g1_epi<1>(acc, P, row0, vcb, hi);
    else if (pn < 8) g1_epi<2>(acc, P, row0, vcb, hi);
    else if (pn < 10) g1_epi<3>(acc, P, row0, vcb, hi);
    else if (pn < 12) g1_epi<4>(acc, P, row0, vcb, hi);
    else if (pn < 14) g1_epi<5>(acc, P, row0, vcb, hi);
    else if (pn < 18) g1_epi<6>(acc, P, row0, vcb, hi);
    else g1_epi<7>(acc, P, row0, vcb, hi);
  }
  {
    int pm = 8 * xg + (jl & 7); const int n0 = 20 * 256 + 128 * (jl >> 3);
    asm volatile("" : "+s"(pm));
    f32x16 acc1[4][1];
#pragma unroll
    for (int mi = 0; mi < 4; ++mi) acc1[mi][0] = f32x16{};
    gemm_loop<1>(Xb + (long)pm * 256 * DM, DM, W + (long)n0 * DM, DM, DM / 64, lds, acc1);
    const int row0 = pm * 256 + 128 * wr + r32, vc0 = n0 + 32 * wc + 16 * hi;
    g1_block<7>(acc1[0][0], P, row0, vc0, hi); SBAR();
    g1_block<7>(acc1[1][0], P, row0 + 32, vc0, hi); SBAR();
    g1_block<7>(acc1[2][0], P, row0 + 64, vc0, hi); SBAR();
    g1_block<7>(acc1[3][0], P, row0 + 96, vc0, hi); SBAR();
  }
}

__device__ __forceinline__ void phase_conv(const Params& p, int g, char* lds) {
  unsigned char* ws = p.ws;
  const bf16_t* U = (const bf16_t*)(ws + OFF_U); const bf16_t* CGb = (const bf16_t*)(ws + OFF_CG); bf16_t* U2 = (bf16_t*)(ws + OFF_U2);
  const int tid = otid(), wid = tid >> 6, lane = tid & 63;
  const int seqlen = (g == 0) ? 16384 : 8192;
  unsigned* IN = (unsigned*)lds;
  float* OUT = (float*)(lds + 65536);
  const int cp = tid & 255, half = tid >> 8;
  float w0[31], w1[31];
#pragma unroll
  for (int j = 0; j < 31; ++j) { f32x2 w = *(const f32x2*)(p.conv_dw + j * 512 + 2 * cp); w0[j] = w[0]; w1[j] = w[1]; }
  const f32x2 cb = *(const f32x2*)(p.conv_dw_b + 2 * cp);
  for (int t = blockIdx.x; t < TG / 32; t += gridDim.x) {
    const int t0 = t * 32, slo = t0 & ~(seqlen - 1), shi = slo + seqlen;
    __syncthreads();
    for (int q = tid; q < 62 * 64; q += NTHR) { int r = q >> 6, c = q & 63; int tok = t0 - 15 + r; u32x4 v = {0u, 0u, 0u, 0u};
      if (tok >= slo && tok < shi) v = *(const u32x4*)(U + (long)tok * 512 + c * 8);
      *(u32x4*)(IN + r * 256 + c * 4) = v; }
    __syncthreads();
    float a0[16], a1[16];
#pragma unroll
    for (int i = 0; i < 16; ++i) { a0[i] = cb[0]; a1[i] = cb[1]; }
#pragma unroll
    for (int ti = 0; ti < 46; ++ti) {
      const unsigned w = IN[(16 * half + ti) * 256 + cp]; const float x0 = bflo(w), x1 = bfhi(w);
#pragma unroll
      for (int to = 0; to < 16; ++to) { const int j = ti - to; if (j >= 0 && j <= 30) { a0[to] = fmaf(w0[j], x0, a0[to]); a1[to] = fmaf(w1[j], x1, a1[to]); } }
    }
#pragma unroll
    for (int to = 0; to < 16; ++to) *(f32x2*)(OUT + (16 * half + to) * 512 + 2 * cp) = f32x2{a0[to], a1[to]};
    __syncthreads();
#pragma unroll
    for (int i = 0; i < 4; ++i) {
      const int tl = wid * 4 + i; const float* src = OUT + tl * 512 + lane * 8;
      f32x4 xa = *(const f32x4*)src, xb = *(const f32x4*)(src + 4);
      float x[8] = {xa[0], xa[1], xa[2], xa[3], xb[0], xb[1], xb[2], xb[3]};
      float s = 0.f;
#pragma unroll
      for (int j = 0; j < 8; ++j) s += x[j];
#pragma unroll
      for (int m = 1; m < 64; m <<= 1) s += __shfl_xor(s, m);
      const float mean = s * (1.f / 512.f); float q = 0.f;
#pragma unroll
      for (int j = 0; j < 8; ++j) { x[j] -= mean; q += x[j] * x[j]; }
#pragma unroll
      for (int m = 1; m < 64; m <<= 1) q += __shfl_xor(q, m);
      const float rstd = rsqrtf(q * (1.f / 512.f) + LN_EPS);
      const long tok = t0 + tl;
      f32x4 g0 = *(const f32x4*)(p.conv_ln_g + lane * 8), g1 = *(const f32x4*)(p.conv_ln_g + lane * 8 + 4);
      f32x4 b0 = *(const f32x4*)(p.conv_ln_b + lane * 8), b1 = *(const f32x4*)(p.conv_ln_b + lane * 8 + 4);
      const float gg[8] = {g0[0], g0[1], g0[2], g0[3], g1[0], g1[1], g1[2], g1[3]}, bb[8] = {b0[0], b0[1], b0[2], b0[3], b1[0], b1[1], b1[2], b1[3]};
      u32x4 cgw = *(const u32x4*)(CGb + tok * 512 + lane * 8);
      const float cgv[8] = {bflo(cgw[0]), bfhi(cgw[0]), bflo(cgw[1]), bfhi(cgw[1]), bflo(cgw[2]), bfhi(cgw[2]), bflo(cgw[3]), bfhi(cgw[3])};
      float o[8];
#pragma unroll
      for (int j = 0; j < 8; ++j) o[j] = siluf_(x[j] * rstd * gg[j] + bb[j]) * cgv[j];
      ST8(U2 + tok * 512 + lane * 8, o, 0);
    }
  }
}

#define KSWZ(row, colB) ((row) * 256 + ((colB) ^ (((row) & 7) << 4)))
constexpr float ATHR = 11.5f;
constexpr int SHM_V = 64 * 128 * 2, SHM_K = 64 * 128 * 2;
__device__ __forceinline__ float vmax3(float a, float b, float c) { float r; asm("v_max3_f32 %0, %1, %2, %3" : "=v"(r) : "v"(a), "v"(b), "v"(c)); return r; }
__device__ __forceinline__ float sm_max_a(const f32x16& p0) {
  float pm = vmax3(p0[0], p0[1], p0[2]);
#pragma unroll
  for (int r = 3; r < 15; r += 2) pm = vmax3(pm, p0[r], p0[r + 1]);
  return pm;
}
template <bool FIRST>
__device__ __forceinline__ void sm_max_b(float pm, f32x16& p0, f32x16& p1, float& m_reg, float& alpha, f32x16& cinit) {
  float pmax = vmax3(pm, p0[15], p1[0]);
#pragma unroll
  for (int r = 1; r < 15; r += 2) pmax = vmax3(pmax, p1[r], p1[r + 1]);
  pmax = fmaxf(pmax, p1[15]);
  { auto rr = __builtin_amdgcn_permlane32_swap(__float_as_uint(pmax), __float_as_uint(pmax), false, false);
    pmax = fmaxf(__uint_as_float(rr[0]), __uint_as_float(rr[1])); }
  alpha = 1.f;
  if (FIRST || !__builtin_expect(__all(pmax <= ATHR), 1)) {
    const float delta = FIRST ? pmax : fmaxf(pmax, 0.f);
    alpha = __builtin_amdgcn_exp2f(-delta); m_reg += delta;
#pragma unroll
    for (int r = 0; r < 16; ++r) { p0[r] -= delta; p1[r] -= delta; cinit[r] = -m_reg; }
  }
}
__device__ __forceinline__ void sm_exp(f32x16& p) {
#pragma unroll
  for (int r = 0; r < 16; ++r) p[r] = __builtin_amdgcn_exp2f(p[r]);
}
__device__ __forceinline__ void finishSM(f32x16& p0, f32x16& p1, float alpha, float& l_reg, bf16x8& pa0, bf16x8& pa1, bf16x8& pa2, bf16x8& pa3) {
  float ps = 0, ps2 = 0;
#pragma unroll
  for (int r = 0; r < 16; ++r) { ps += p0[r]; ps2 += p1[r]; }
  ps += ps2;
  { auto rr = __builtin_amdgcn_permlane32_swap(__float_as_uint(ps), __float_as_uint(ps), false, false);
    ps = __uint_as_float(rr[0]) + __uint_as_float(rr[1]); }
  l_reg = l_reg * alpha + ps;
#define PK4(P, BASE, OUT) do { u32x4 w = {cvtpk(P[BASE + 0], P[BASE + 1]), cvtpk(P[BASE + 2], P[BASE + 3]), cvtpk(P[BASE + 4], P[BASE + 5]), cvtpk(P[BASE + 6], P[BASE + 7])}; \
    OUT = *reinterpret_cast<bf16x8*>(&w); } while (0)
  PK4(p0, 0, pa0); PK4(p0, 8, pa1); PK4(p1, 0, pa2); PK4(p1, 8, pa3);
#undef PK4
}
__device__ __forceinline__ void qkt(f32x16& p0, f32x16& p1, const char* Ks, const bf16x8* qr, int r32, int hi, int comp, const f32x16& cinit) {
#pragma unroll
  for (int d0 = 0; d0 < 4; ++d0) { int cb = (comp * 64 + d0 * 16 + hi * 8) * 2;
    bf16x8 b0 = *reinterpret_cast<const bf16x8*>(Ks + KSWZ(r32, cb));
    bf16x8 b1 = *reinterpret_cast<const bf16x8*>(Ks + KSWZ(32 + r32, cb));
    if (d0 == 0) { p0 = __builtin_amdgcn_mfma_f32_32x32x16_bf16(b0, qr[d0], cinit, 0, 0, 0); p1 = __builtin_amdgcn_mfma_f32_32x32x16_bf16(b1, qr[d0], cinit, 0, 0, 0); }
    else { p0 = __builtin_amdgcn_mfma_f32_32x32x16_bf16(b0, qr[d0], p0, 0, 0, 0); p1 = __builtin_amdgcn_mfma_f32_32x32x16_bf16(b1, qr[d0], p1, 0, 0, 0); } }
}
__device__ __forceinline__ int v_st(int k, int c) { const int kk = (k & ~0xC) | ((k & 4) << 1) | ((k & 8) >> 1); return ((kk >> 3) * 4 + (c >> 5)) * 512 + ((kk & 7) * 32 + (c & 31)) * 2; }
__device__ __forceinline__ int v_rd_base(int lane) { return ((lane & 3) << 3) | (((lane >> 2) & 3) << 6) | (((lane >> 4) & 1) << 5) | (((lane >> 5) & 1) << 8); }
constexpr int v_rd_off(int d0, int ks, int half) { return d0 * 512 + ks * 4096 + half * 2048; }
template <int OFF> __device__ __forceinline__ s16x4 tr_read(int vb) {
  s16x4 r; asm volatile("ds_read_b64_tr_b16 %0, %1 offset:%2" : "=&v"(r) : "v"(vb), "i"(OFF) : "memory"); return r;
}
template <int D0> __device__ __forceinline__ void pv_one(f32x16& od, int vb, bf16x8 pa0, bf16x8 pa1, bf16x8 pa2, bf16x8 pa3) {
  const s16x4 l0 = tr_read<v_rd_off(D0, 0, 0)>(vb), h0 = tr_read<v_rd_off(D0, 0, 1)>(vb), l1 = tr_read<v_rd_off(D0, 1, 0)>(vb), h1 = tr_read<v_rd_off(D0, 1, 1)>(vb);
  const s16x4 l2 = tr_read<v_rd_off(D0, 2, 0)>(vb), h2 = tr_read<v_rd_off(D0, 2, 1)>(vb), l3 = tr_read<v_rd_off(D0, 3, 0)>(vb), h3 = tr_read<v_rd_off(D0, 3, 1)>(vb);
  asm volatile("s_waitcnt lgkmcnt(0)" ::: "memory"); SBAR();
#define PK(L, H) (bf16x8){L[0], L[1], L[2], L[3], H[0], H[1], H[2], H[3]}
  od = __builtin_amdgcn_mfma_f32_32x32x16_bf16(pa0, PK(l0, h0), od, 0, 0, 0);
  od = __builtin_amdgcn_mfma_f32_32x32x16_bf16(pa1, PK(l1, h1), od, 0, 0, 0);
  od = __builtin_amdgcn_mfma_f32_32x32x16_bf16(pa2, PK(l2, h2), od, 0, 0, 0);
  od = __builtin_amdgcn_mfma_f32_32x32x16_bf16(pa3, PK(l3, h3), od, 0, 0, 0);
#undef PK
}

typedef float f32x2_t_ __attribute__((ext_vector_type(2))); typedef __bf16 bf16x2_t_ __attribute__((ext_vector_type(2)));
__device__ __forceinline__ unsigned cvtpk_s(float lo, float hi) { f32x2_t_ v = {lo, hi}; bf16x2_t_ b = __builtin_convertvector(v, bf16x2_t_); return __builtin_bit_cast(unsigned, b); }
typedef __attribute__((address_space(3))) const char* lds_cptr;
typedef short v4i16_t_ __attribute__((ext_vector_type(4)));
__device__ __forceinline__ s16x4 vtr(lds_cptr p) { return __builtin_bit_cast(s16x4, __builtin_amdgcn_ds_read_tr16_b64_v4i16((__attribute__((address_space(3))) v4i16_t_*)p)); }
__device__ __forceinline__ void attn_unit(const bf16_t* __restrict__ Qb, const bf16_t* __restrict__ Kh, const bf16_t* __restrict__ Vh, const bf16_t* __restrict__ AGb,
                                          bf16_t* __restrict__ O2b, int seq, float lam, const float* __restrict__ subg, char* lds) {
  constexpr int LDK = 512;
  const int tid = otid(), wid = tid >> 6, lane = tid & 63, r32 = lane & 31, hi = lane >> 5, rowgrp = wid & 3, comp = wid >> 2;
  constexpr int BUFB = SHM_V + SHM_K;
  float* wsl = (float*)(lds + 3 * BUFB) + wid * 64; float* li_l = wsl; float* al_l = wsl + 32;
  float m_reg = 0.f, l_reg = 0; f32x16 o[4] = {}; bf16x8 qr[4]; f32x16 cinit = {};
  const int vb0 = (int)(uintptr_t)lds + v_rd_base(lane);
  const int wid_s = __builtin_amdgcn_readfirstlane(wid);
  const bf16_t* ksrc[2]; const bf16_t* vsrc[2];
#pragma unroll
  for (int i = 0; i < 2; ++i) {
    const int pk = 2 * wid + i, row = 4 * pk + (lane >> 4), chunk = (lane & 15) ^ (row & 7);
    ksrc[i] = Kh + (long)row * LDK + chunk * 8;
    const int q = 64 * pk + lane, sti = q >> 5, kkl = (q >> 2) & 7, cq = q & 3, kk = (sti >> 2) * 8 + kkl, c = (sti & 3) * 32 + cq * 8, k = kk;
    vsrc[i] = Vh + (long)k * LDK + c;
  }
#define DMA_TILE(t, ob) do { char* d_ = lds + (ob) + wid_s * 2048; const long to_ = (long)(t) * 64 * LDK;                                  \
    __builtin_amdgcn_global_load_lds((const unsigned*)(vsrc[0] + to_), (unsigned*)(d_), 16, 0, 0);                                              \
    __builtin_amdgcn_global_load_lds((const unsigned*)(vsrc[1] + to_), (unsigned*)(d_ + 1024), 16, 0, 0);                                       \
    __builtin_amdgcn_global_load_lds((const unsigned*)(ksrc[0] + to_), (unsigned*)(d_ + SHM_V), 16, 0, 0);                                      \
    __builtin_amdgcn_global_load_lds((const unsigned*)(ksrc[1] + to_), (unsigned*)(d_ + SHM_V + 1024), 16, 0, 0); } while (0)
#define TILE_BAR() do { asm volatile("s_waitcnt vmcnt(0) lgkmcnt(0)" ::: "memory"); __builtin_amdgcn_s_barrier(); asm volatile("" ::: "memory"); } while (0)
#define RESC(a) do { if (__any((a) < 1.f)) { if (hi == 0) al_l[r32] = (a); asm volatile("s_waitcnt lgkmcnt(0)" ::: "memory"); \
    _Pragma("unroll") for (int d = 0; d < 4; ++d) _Pragma("unroll") for (int r = 0; r < 16; ++r) o[d][r] *= al_l[crow(r, hi)]; } } while (0)
  DMA_TILE(0, 0); DMA_TILE(1, BUFB);
  const bf16_t* Qw = Qb + (long)(rowgrp * 32 + r32) * LDK + comp * 64 + hi * 8;
#pragma unroll
  for (int d0 = 0; d0 < 4; ++d0) qr[d0] = *(const bf16x8*)(Qw + d0 * 16);
  f32x16 pA0, pA1, pB0, pB1; float alA, alB; bf16x8 pa0, pa1, pa2, pa3; const int NT = seq / 64;
  float pmx;
#define PV_SM(VB, P0, P1, AL) do {                                                                    \
    pv_one<0>(o[0], VB, pa0, pa1, pa2, pa3); pmx = sm_max_a(P0);                                       \
    pv_one<1>(o[1], VB, pa0, pa1, pa2, pa3); sm_max_b<false>(pmx, P0, P1, m_reg, AL, cinit);           \
    pv_one<2>(o[2], VB, pa0, pa1, pa2, pa3); sm_exp(P0);                                               \
    pv_one<3>(o[3], VB, pa0, pa1, pa2, pa3); sm_exp(P1); } while (0)
  TILE_BAR();
  qkt(pA0, pA1, lds + SHM_V, qr, r32, hi, comp, cinit); pmx = sm_max_a(pA0); sm_max_b<true>(pmx, pA0, pA1, m_reg, alA, cinit); alA = 1.f; sm_exp(pA0); sm_exp(pA1);
  int obp = 0, obc = BUFB, obn = 2 * BUFB;
  const int kx0 = r32 * 256 + ((comp * 128 + 0 * 32 + hi * 16) ^ ((r32 & 7) << 4)), kx1 = r32 * 256 + ((comp * 128 + 1 * 32 + hi * 16) ^ ((r32 & 7) << 4));
  const int kx2 = r32 * 256 + ((comp * 128 + 2 * 32 + hi * 16) ^ ((r32 & 7) << 4)), kx3 = r32 * 256 + ((comp * 128 + 3 * 32 + hi * 16) ^ ((r32 & 7) << 4));
  const int vrb = v_rd_base(lane);
#define PIN(x) asm volatile("" : "+v"(x))
#define MX3(a, b, c) __builtin_fmaxf(__builtin_fmaxf((a), (b)), (c))
#define KF(off) (*reinterpret_cast<const bf16x8*>(kb_ + (off)))
#define KP(p) (*reinterpret_cast<const bf16x8*>(p))
#define MF(a, b, c) __builtin_amdgcn_mfma_f32_32x32x16_bf16(a, b, c, 0, 0, 0)
#define VRD(i) do { vlo[i] = vtr(vp_ + v_rd_off((i) & 3, (i) >> 2, 0)); vhi[i] = vtr(vp_ + v_rd_off((i) & 3, (i) >> 2, 1)); } while (0)
#define VFR(i) (bf16x8){vlo[i][0], vlo[i][1], vlo[i][2], vlo[i][3], vhi[i][0], vhi[i][1], vhi[i][2], vhi[i][3]}
#define SWP(OUT) do { u32x4 w_ = {ca0, ca1, cb0, cb1}; OUT = *reinterpret_cast<bf16x8*>(&w_); } while (0)
#define GQA(MFS, P, B) do { MFS; sacc += P[B]; sacc += P[B + 1]; sacc += P[B + 2]; sacc += P[B + 3]; PIN(sacc); ca0 = cvtpk_s(P[B], P[B + 1]); ca1 = cvtpk_s(P[B + 2], P[B + 3]); PIN(ca0); PIN(ca1); SBAR(); } while (0)
#define GQB(MFS, P, B, OUT) do { MFS; sacc += P[B]; sacc += P[B + 1]; sacc += P[B + 2]; sacc += P[B + 3]; PIN(sacc); cb0 = cvtpk_s(P[B], P[B + 1]); cb1 = cvtpk_s(P[B + 2], P[B + 3]); SWP(OUT); PIN(OUT); SBAR(); } while (0)
#define GPM(i, PAk, X0, X1, X2, X3) do { if ((i) + 2 < 16) VRD((i) + 2); o[(i) & 3] = MF(PAk, VFR(i), o[(i) & 3]); rm_ = MX3(rm_, X0, X1); rm_ = MX3(rm_, X2, X3); PIN(rm_); SBAR(); } while (0)
#define GPE(i, PAk, X, B) do { if ((i) + 2 < 16) VRD((i) + 2); o[(i) & 3] = MF(PAk, VFR(i), o[(i) & 3]); X[B] = __builtin_amdgcn_exp2f(X[B]); X[B + 1] = __builtin_amdgcn_exp2f(X[B + 1]); \
    X[B + 2] = __builtin_amdgcn_exp2f(X[B + 2]); X[B + 3] = __builtin_amdgcn_exp2f(X[B + 3]); PIN(X); SBAR(); } while (0)
#define GPX(i, PAk, X, B) do { if ((i) + 2 < 16) VRD((i) + 2); o[(i) & 3] = MF(PAk, VFR(i), o[(i) & 3]); X[B] = __builtin_amdgcn_exp2f(X[B]); X[B + 1] = __builtin_amdgcn_exp2f(X[B + 1]); PIN(X); SBAR(); } while (0)
#define STEP(C0, C1, P0, P1, AL) do { SBAR();                                                                                    \
    const char* kb_ = lds + obc + SHM_V; const lds_cptr vp_ = (lds_cptr)lds + obp + vrb;                                            \
    s16x4 vlo[16], vhi[16]; unsigned ca0, ca1, cb0, cb1; float sacc = 0.f;                                                        \
    const char* k0_ = kb_ + kx0; const char* k1_ = kb_ + kx1; const char* k2_ = kb_ + kx2; const char* k3_ = kb_ + kx3;                 \
    const bf16x8 kf0 = KP(k0_), kf1 = KP(k0_ + 8192), kf2 = KP(k1_), kf3 = KP(k1_ + 8192); SBAR();                                \
    GQA(C0 = MF(kf0, qr[0], cinit), P0, 0);                                                                                       \
    const bf16x8 kf4 = KP(k2_), kf5 = KP(k2_ + 8192), kf6 = KP(k3_), kf7 = KP(k3_ + 8192);                                        \
    GQB(C1 = MF(kf1, qr[0], cinit), P0, 4, pa0);                                                                                  \
    GQA(C0 = MF(kf2, qr[1], C0), P0, 8);  GQB(C1 = MF(kf3, qr[1], C1), P0, 12, pa1);                                              \
    VRD(0);                                                                                                                       \
    GQA(C0 = MF(kf4, qr[2], C0), P1, 0);  GQB(C1 = MF(kf5, qr[2], C1), P1, 4, pa2);                                               \
    VRD(1);                                                                                                                       \
    GQA(C0 = MF(kf6, qr[3], C0), P1, 8);  GQB(C1 = MF(kf7, qr[3], C1), P1, 12, pa3);                                              \
    float ps_; { auto rr_ = __builtin_amdgcn_permlane32_swap(__float_as_uint(sacc), __float_as_uint(sacc), false, false);        \
      ps_ = __uint_as_float(rr_[0]) + __uint_as_float(rr_[1]); }                                                                  \
    l_reg += ps_; AL = 1.f;                                                                                                       \
    if (!__builtin_expect(__all(ps_ <= PTHR), 1)) { const float dl_ = fmaxf(__log2f(ps_), 0.f); AL = __builtin_amdgcn_exp2f(-dl_); m_reg += dl_;   \
      _Pragma("unroll") for (int r = 0; r < 16; ++r) { C0[r] -= dl_; C1[r] -= dl_; cinit[r] = -m_reg; } }                            \
    SBAR();                                                                                                                       \
    GPX(0, pa0, C0, 0);  GPX(1, pa0, C0, 2);  GPX(2, pa0, C0, 4);   GPX(3, pa0, C0, 6);                                           \
    GPX(4, pa1, C0, 8);  GPX(5, pa1, C0, 10); GPX(6, pa1, C0, 12);  GPX(7, pa1, C0, 14);                                          \
    GPX(8, pa2, C1, 0);  GPX(9, pa2, C1, 2);  GPX(10, pa2, C1, 4);  GPX(11, pa2, C1, 6);                                          \
    GPX(12, pa3, C1, 8); GPX(13, pa3, C1, 10); GPX(14, pa3, C1, 12); GPX(15, pa3, C1, 14);                                        \
    if (__any(AL < 1.f)) { if (hi == 0) al_l[r32] = AL; asm volatile("s_waitcnt lgkmcnt(0)" ::: "memory"); l_reg *= AL;          \
      _Pragma("unroll") for (int d = 0; d < 4; ++d) _Pragma("unroll") for (int r = 0; r < 16; ++r) o[d][r] *= al_l[crow(r, hi)]; } \
  } while (0)
  constexpr float PTHR = 2896.3f;
  { float alS;
  for (int j = 1; j + 1 < NT; j += 2) {
    DMA_TILE(j + 1, obn);
    STEP(pB0, pB1, pA0, pA1, alS);
    TILE_BAR();
    { const int t_ = obp; obp = obc; obc = obn; obn = t_; }
    if (j + 2 < NT) DMA_TILE(j + 2, obn);
    STEP(pA0, pA1, pB0, pB1, alS);
    TILE_BAR();
    { const int t_ = obp; obp = obc; obc = obn; obn = t_; }
  } }
  alA = 1.f;
#undef GPX
#undef STEP
#undef GPE
#undef GPM
#undef GQB
#undef GQA
#undef SWP
#undef VFR
#undef VRD
#undef MF
#undef KF
#undef KP
#undef PIN
#undef MX3
  SBAR(); qkt(pB0, pB1, lds + obc + SHM_V, qr, r32, hi, comp, cinit);
  finishSM(pA0, pA1, alA, l_reg, pa0, pa1, pa2, pa3); SBAR();
  PV_SM(vb0 + obp, pB0, pB1, alB);
  RESC(alB);
  finishSM(pB0, pB1, alB, l_reg, pa0, pa1, pa2, pa3); SBAR();
  pv_one<0>(o[0], vb0 + obc, pa0, pa1, pa2, pa3); pv_one<1>(o[1], vb0 + obc, pa0, pa1, pa2, pa3);
  pv_one<2>(o[2], vb0 + obc, pa0, pa1, pa2, pa3); pv_one<3>(o[3], vb0 + obc, pa0, pa1, pa2, pa3);
#undef PV_SM
#undef DMA_TILE
#undef TILE_BAR
#undef RESC
  asm volatile("s_waitcnt vmcnt(0)" ::: "memory");
  __syncthreads();
  float* X = (float*)lds;
  if (hi == 0) li_l[r32] = l_reg;
  asm volatile("s_waitcnt lgkmcnt(0)" ::: "memory");
  float rli[16];
#pragma unroll
  for (int r = 0; r < 16; ++r) rli[r] = __builtin_amdgcn_rcpf(li_l[crow(r, hi)]);
  if (comp == 0) {
#pragma unroll
    for (int r = 0; r < 16; ++r)
#pragma unroll
      for (int d0 = 0; d0 < 4; ++d0) X[(rowgrp * 32 + crow(r, hi)) * 128 + d0 * 32 + r32] = o[d0][r] * rli[r];
  }
  __syncthreads();
  if (comp == 1) {
#pragma unroll
    for (int r = 0; r < 16; ++r)
#pragma unroll
      for (int d0 = 0; d0 < 4; ++d0) { float* xp = X + (rowgrp * 32 + crow(r, hi)) * 128 + d0 * 32 + r32; *xp = *xp - lam * (o[d0][r] * rli[r]); }
  }
  __syncthreads();
  {
    const int row = tid >> 2, c0 = (tid & 3) * 32;
    float v[32]; float ss = 0.f;
#pragma unroll
    for (int i = 0; i < 8; ++i) { f32x4 x4 = *(const f32x4*)(X + row * 128 + c0 + 4 * i); v[4 * i] = x4[0]; v[4 * i + 1] = x4[1]; v[4 * i + 2] = x4[2]; v[4 * i + 3] = x4[3]; }
#pragma unroll
    for (int i = 0; i < 32; ++i) ss += v[i] * v[i];
    ss += __shfl_xor(ss, 1); ss += __shfl_xor(ss, 2);
    const float rs = rsqrtf(ss * (1.f / 128.f) + LN_EPS) * (1.f - LAM_INIT);
#pragma unroll
    for (int i = 0; i < 4; ++i) {
      u32x4 gw = *(const u32x4*)(AGb + (long)row * 512 + c0 + 8 * i);
      f32x4 s0 = *(const f32x4*)(subg + c0 + 8 * i), s1 = *(const f32x4*)(subg + c0 + 8 * i + 4);
      float ov[8];
      ov[0] = v[8 * i + 0] * rs * s0[0] * bflo(gw[0]); ov[1] = v[8 * i + 1] * rs * s0[1] * bfhi(gw[0]);
      ov[2] = v[8 * i + 2] * rs * s0[2] * bflo(gw[1]); ov[3] = v[8 * i + 3] * rs * s0[3] * bfhi(gw[1]);
      ov[4] = v[8 * i + 4] * rs * s1[0] * bflo(gw[2]); ov[5] = v[8 * i + 5] * rs * s1[1] * bfhi(gw[2]);
      ov[6] = v[8 * i + 6] * rs * s1[2] * bflo(gw[3]); ov[7] = v[8 * i + 7] * rs * s1[3] * bfhi(gw[3]);
      ST8(O2b + (long)row * 512 + c0 + 8 * i, ov, 0);
    }
  }
  __syncthreads();
}

__device__ __forceinline__ void phase_attn(const Params& p, int g, char* lds, int vid) {
  unsigned char* ws = p.ws;
  const bf16_t* Qb = (const bf16_t*)(ws + OFF_Q); const bf16_t* Kb = (const bf16_t*)(ws + OFF_K); const bf16_t* Vb = (const bf16_t*)(ws + OFF_V);
  const bf16_t* AGb = (const bf16_t*)(ws + OFF_AG); bf16_t* O2 = (bf16_t*)(ws + OFF_O2);
  const float lam = *(const float*)(ws + OFF_MISC);
  const int x = vid & 7, jj = vid >> 3, nper = 32;
  for (int u = jj; u < 64; u += nper) {
    int head, seq0, seq, qb;
    if (g == 0) { head = x >> 1; seq0 = 0; seq = 16384; qb = (x & 1) * 64 + u; }
    else { head = x & 3; seq0 = (x >> 2) * 8192; seq = 8192; qb = u; }
    const long qrow = seq0 + (long)qb * 128;
    attn_unit(Qb + qrow * 512 + head * 128, Kb + (long)seq0 * 512 + head * 128, Vb + (long)seq0 * 512 + head * 128, AGb + qrow * 512 + head * 128,
              O2 + qrow * 512 + head * 128, seq, lam, p.subln_g, lds);
  }
}

__device__ __forceinline__ void g2_block(const f32x16& a1, const f32x16& a2, const bf16_t* MCb, const bf16_t* MAb, bf16_t* MG, const float* bcp, long row, int c0) {
  u32x4 mc0 = *(const u32x4*)(MCb + row * 1024 + c0), mc1 = *(const u32x4*)(MCb + row * 1024 + c0 + 8);
  u32x4 ma0 = *(const u32x4*)(MAb + row * 1024 + c0), ma1 = *(const u32x4*)(MAb + row * 1024 + c0 + 8);
  float bc[16];
#pragma unroll
  for (int j = 0; j < 4; ++j) { f32x4 b4 = *(const f32x4*)(bcp + c0 + 4 * j); bc[4 * j] = b4[0]; bc[4 * j + 1] = b4[1]; bc[4 * j + 2] = b4[2]; bc[4 * j + 3] = b4[3]; }
  float o[16];
#pragma unroll
  for (int j = 0; j < 4; ++j) {
    o[2 * j] = bflo(mc0[j]) * (a1[2 * j] + bc[2 * j]) + bflo(ma0[j]) * a2[2 * j];
    o[2 * j + 1] = bfhi(mc0[j]) * (a1[2 * j + 1] + bc[2 * j + 1]) + bfhi(ma0[j]) * a2[2 * j + 1];
    o[8 + 2 * j] = bflo(mc1[j]) * (a1[8 + 2 * j] + bc[8 + 2 * j]) + bflo(ma1[j]) * a2[8 + 2 * j];
    o[8 + 2 * j + 1] = bfhi(mc1[j]) * (a1[8 + 2 * j + 1] + bc[8 + 2 * j + 1]) + bfhi(ma1[j]) * a2[8 + 2 * j + 1];
  }
  ST8(MG + row * 1024 + c0, o, 0); ST8(MG + row * 1024 + c0 + 8, o, 8);
}
__device__ __forceinline__ void phase_gemm2(const Params& p, char* lds, int vid) {
  unsigned char* ws = p.ws;
  const bf16_t* U2 = (const bf16_t*)(ws + OFF_U2); const bf16_t* O2 = (const bf16_t*)(ws + OFF_O2);
  const bf16_t* Wcp = (const bf16_t*)(ws + OFF_WCP); const bf16_t* Wao = (const bf16_t*)(ws + OFF_WAO);
  const bf16_t* MCb = (const bf16_t*)(ws + OFF_MC); const bf16_t* MAb = (const bf16_t*)(ws + OFF_MA); bf16_t* MG = (bf16_t*)(ws + OFF_XB);
  const int tid = otid(), wid = tid >> 6, lane = tid & 63, wr = wid >> 2, wc = wid & 3, r32 = lane & 31, hi = lane >> 5;
  const int xg = vid & 7, jl = vid >> 3;
  for (int rnd = 0; rnd < 2; ++rnd) {
    int pm = 8 * xg + (jl & 7); const int pn = rnd * 4 + (jl >> 3);
    asm volatile("" : "+s"(pm));
    f32x16 a1[4][1], a2[4][1];
#pragma unroll
    for (int mi = 0; mi < 4; ++mi) { a1[mi][0] = f32x16{}; a2[mi][0] = f32x16{}; }
    gemm_loop<1>(U2 + (long)pm * 256 * 512, 512, Wcp + (long)pn * 128 * 512, 512, 8, lds, a1);
    gemm_loop<1>(O2 + (long)pm * 256 * 512, 512, Wao + (long)pn * 128 * 512, 512, 8, lds, a2);
    const int c0 = pn * 128 + 32 * wc + 16 * hi;
    const long row0 = pm * 256 + 128 * wr + r32;
    g2_block(a1[0][0], a2[0][0], MCb, MAb, MG, p.b_cp, row0, c0); SBAR();
    g2_block(a1[1][0], a2[1][0], MCb, MAb, MG, p.b_cp, row0 + 32, c0); SBAR();
    g2_block(a1[2][0], a2[2][0], MCb, MAb, MG, p.b_cp, row0 + 64, c0); SBAR();
    g2_block(a1[3][0], a2[3][0], MCb, MAb, MG, p.b_cp, row0 + 96, c0); SBAR();
  }
}

__device__ __forceinline__ void phase_gemm3(const Params& p, int g, char* lds, int vid) {
  unsigned char* ws = p.ws;
  const bf16_t* MG = (const bf16_t*)(ws + OFF_XB); const bf16_t* Wo = (const bf16_t*)(ws + OFF_WOUT);
  const float* x = p.x[g]; float* out = p.out + (size_t)g * TG * DM;
  const int tid = otid(), wid = tid >> 6, lane = tid & 63, wr = wid >> 2, wc = wid & 3, r32 = lane & 31, hi = lane >> 5;
  const int xg = vid & 7, jl = vid >> 3;
  {
    const int pm = 8 * xg + (jl & 7), pn = (jl >> 3);
    f32x16 acc[4][2];
#pragma unroll
    for (int mi = 0; mi < 4; ++mi)
#pragma unroll
      for (int ni = 0; ni < 2; ++ni) acc[mi][ni] = f32x16{};
    gemm_loop<2>(MG + (long)pm * 256 * DM, DM, Wo + (long)pn * 256 * DM, DM, DM / 64, lds, acc);
#pragma unroll
    for (int ni = 0; ni < 2; ++ni) {
      const int c0 = pn * 256 + 64 * wc + 32 * ni + 16 * hi;
      f32x4 bo[4];
#pragma unroll
      for (int j = 0; j < 4; ++j) bo[j] = *(const f32x4*)(p.b_out + c0 + 4 * j);
#pragma unroll
      for (int mi = 0; mi < 4; ++mi) {
        const long row = pm * 256 + 128 * wr + 32 * mi + r32;
#pragma unroll
        for (int j = 0; j < 4; ++j) {
          f32x4 xv = *(const f32x4*)(x + row * DM + c0 + 4 * j); f32x4 r;
          r[0] = acc[mi][ni][4 * j] + bo[j][0] + ALPHA * xv[0]; r[1] = acc[mi][ni][4 * j + 1] + bo[j][1] + ALPHA * xv[1];
          r[2] = acc[mi][ni][4 * j + 2] + bo[j][2] + ALPHA * xv[2]; r[3] = acc[mi][ni][4 * j + 3] + bo[j][3] + ALPHA * xv[3];
          *(f32x4*)(out + row * DM + c0 + 4 * j) = r;
        }
      }
    }
  }
}

namespace pg8 {
#define PG8_LAS __attribute__((address_space(3)))
constexpr int BM = 256, BK = 64, HALF = 128, HTB = HALF * BK * 2, STAGE_BYTES = 8 * HTB;
__device__ __forceinline__ int lds_byte(int r, int c) { const int st = (r >> 4) * 2 + (c >> 5), rr = r & 15, cc = c & 31, ob = rr * 64 + cc * 2; return st * 1024 + (ob ^ (((ob >> 9) & 1) << 5)); }
__device__ __forceinline__ void stage_rc(int b, int& R, int& C) { const int st = b / 1024, sb = b % 1024, swz = sb ^ (((sb >> 9) & 1) << 5); R = (st >> 1) * 16 + swz / 64; C = (st & 1) * 32 + (swz % 64) / 2; }
__device__ __forceinline__ int perm32(int rho) { const int n = rho >> 4, i = rho & 15; return 8 * (i >> 2) + 4 * n + (i & 3); }
struct Unit { int pm, pn; };
struct Gemm { const bf16_t* A; const bf16_t* Bt; int M, N, K; };
struct GroupOrder {
  int xg, jl, npn;
  __device__ __forceinline__ bool next(int i, Unit& u) const { int pm_ = 8 * xg + (jl & 7); asm volatile("" : "+s"(pm_));
    u.pm = pm_; u.pn = 4 * i + (jl >> 3); return u.pn < npn; }
  __device__ __forceinline__ void a_ready(const Unit&) const {}
  __device__ __forceinline__ void done(const Unit&) const {}
};
template <class Epi, class Sched, bool ALIGN_EPI = false, bool SP2 = false>
__device__ __forceinline__ void gemm_phase(PG8_LAS unsigned char* lds, const Gemm g, const Sched& S, const Epi& E) {
    const int tid = otid(), wid = __builtin_amdgcn_readfirstlane(tid >> 6), lane = tid & 63, wr = wid >> 2, wc = wid & 3, fr = lane & 15, fq = lane >> 4;
    const int K = g.K, nt = K / BK;
    unsigned voffA[2], voffB[2];
#pragma unroll
    for (int i = 0; i < 2; ++i) { int R, C; stage_rc(tid * 16 + i * 8192, R, C); const int Rb = Epi::PERM ? ((R & ~31) + perm32(R & 31)) : R;
        voffA[i] = (unsigned)(R * K + C) * 2u; voffB[i] = (unsigned)(Rb * K + C) * 2u; }
    const size_t kstep = (size_t)(BK * 2);
    const size_t hstep = (size_t)HALF * K * 2;
    const size_t tstep = 2 * hstep;
    const unsigned ldsw = (unsigned)wid * 1024u;
    const int aoff = lds_byte(wr * 64 + fr, fq * 8), boff = lds_byte(wc * 32 + fr, fq * 8);
#define PG8_SA(b, h) (((b) * 2 + (h)) * HTB)
#define PG8_SB(b, h) ((4 + (b) * 2 + (h)) * HTB)
#define PG8_STAGE(bufoff, gbase, voff) do { _Pragma("unroll") for (int _i = 0; _i < 2; ++_i) \
        __builtin_amdgcn_global_load_lds((const unsigned*)((const char*)(gbase) + (voff)[_i]), (PG8_LAS unsigned*)(lds + (bufoff) + ldsw + _i * 8192), 16, 0, 0); } while (0)
#define PG8_LDA(dst, b, h) do { _Pragma("unroll") for (int m = 0; m < 4; ++m) _Pragma("unroll") for (int k = 0; k < 2; ++k) dst[m][k] = *(const PG8_LAS bf16x8*)(lds + PG8_SA(b, h) + aoff + m * 2048 + k * 1024); } while (0)
#define PG8_LDB(dst, b, h) do { _Pragma("unroll") for (int n = 0; n < 2; ++n) _Pragma("unroll") for (int k = 0; k < 2; ++k) dst[n][k] = *(const PG8_LAS bf16x8*)(lds + PG8_SB(b, h) + boff + n * 2048 + k * 1024); } while (0)
#define PG8_MMA(ai, bj, At, Bt) do { __builtin_amdgcn_s_setprio(1); _Pragma("unroll") for (int m = 0; m < 4; ++m) _Pragma("unroll") for (int n = 0; n < 2; ++n) _Pragma("unroll") for (int k = 0; k < 2; ++k) \
        acc[ai][bj][m][n] = __builtin_amdgcn_mfma_f32_16x16x32_bf16(Bt[n][k], At[m][k], acc[ai][bj][m][n], 0, 0, 0); __builtin_amdgcn_s_setprio(0); } while (0)
#define PG8_WAIT_V(n) asm volatile("s_waitcnt vmcnt(" #n ")" ::: "memory")
#define PG8_WAIT_L(n) asm volatile("s_waitcnt lgkmcnt(" #n ")" ::: "memory")
#define PG8_BAR __builtin_amdgcn_s_barrier()
#define PG8_SCHED __builtin_amdgcn_sched_barrier(0)
    Unit cur, nxt; int ui = 0;
    if (!S.next(0, cur)) return;
    f32x4 acc[2][2][4][2];
#pragma unroll
    for (int a = 0; a < 2; ++a)
#pragma unroll
        for (int b = 0; b < 2; ++b)
#pragma unroll
            for (int m = 0; m < 4; ++m)
#pragma unroll
                for (int n = 0; n < 2; ++n) acc[a][b][m][n] = (f32x4){0.f, 0.f, 0.f, 0.f};
    bf16x8 At[4][2], B0[2][2], B1[2][2];
    const char* cA = (const char*)g.A + (size_t)cur.pm * tstep; const char* cB = (const char*)g.Bt + (size_t)cur.pn * tstep;
    S.a_ready(cur);
    if constexpr (SP2) {
        PG8_STAGE(PG8_SB(0, 0), cB, voffB); PG8_STAGE(PG8_SB(0, 1), cB + hstep, voffB); PG8_STAGE(PG8_SA(0, 0), cA, voffA); PG8_STAGE(PG8_SA(0, 1), cA + hstep, voffA);
        if (wr == 1) PG8_BAR;
        PG8_WAIT_V(2); PG8_BAR;
        PG8_STAGE(PG8_SB(1, 0), cB + kstep, voffB); PG8_STAGE(PG8_SA(1, 0), cA + kstep, voffA); PG8_STAGE(PG8_SB(1, 1), cB + hstep + kstep, voffB);
        PG8_WAIT_V(6); PG8_BAR;
    } else {
        PG8_STAGE(PG8_SB(0, 0), cB, voffB); PG8_STAGE(PG8_SA(0, 0), cA, voffA); PG8_STAGE(PG8_SB(0, 1), cB + hstep, voffB); PG8_STAGE(PG8_SA(0, 1), cA + hstep, voffA);
        if (wr == 1) PG8_BAR;
        PG8_WAIT_V(4); PG8_BAR;
        PG8_STAGE(PG8_SB(1, 0), cB + kstep, voffB); PG8_STAGE(PG8_SA(1, 0), cA + kstep, voffA); PG8_STAGE(PG8_SB(1, 1), cB + hstep + kstep, voffB);
        PG8_WAIT_V(6); PG8_BAR;
    }
    for (;;) {
        const bool has_next = S.next(ui + 1, nxt);
        const char* nA = has_next ? (const char*)g.A + (size_t)nxt.pm * tstep : cA; const char* nB = has_next ? (const char*)g.Bt + (size_t)nxt.pn * tstep : cB;
        for (int t = 0; t < nt; t += 2) {
            const bool last = (t == nt - 2);
            const char* a1 = cA + (size_t)(t + 1) * kstep;
            const char* a2 = last ? nA : cA + (size_t)(t + 2) * kstep; const char* b2 = last ? nB : cB + (size_t)(t + 2) * kstep;
            const char* a3 = a2 + kstep; const char* b3 = b2 + kstep;
            if (last && has_next) S.a_ready(nxt);
            if constexpr (SP2) {
            PG8_LDB(B0, 0, 0); PG8_LDB(B1, 0, 1); PG8_SCHED; PG8_LDA(At, 0, 0); PG8_STAGE(PG8_SA(1, 1), a1 + hstep, voffA);
            PG8_WAIT_V(8); PG8_WAIT_L(0); PG8_BAR; PG8_MMA(0, 0, At, B0); PG8_MMA(0, 1, At, B1); PG8_BAR; PG8_SCHED;
            PG8_LDA(At, 0, 1); PG8_STAGE(PG8_SB(0, 0), b2, voffB); PG8_STAGE(PG8_SB(0, 1), b2 + hstep, voffB); PG8_STAGE(PG8_SA(0, 0), a2, voffA);
            PG8_WAIT_V(8); PG8_WAIT_L(0); PG8_BAR; PG8_MMA(1, 0, At, B0); PG8_MMA(1, 1, At, B1); PG8_BAR; PG8_SCHED;
            PG8_LDB(B0, 1, 0); PG8_LDB(B1, 1, 1); PG8_SCHED; PG8_LDA(At, 1, 0); PG8_STAGE(PG8_SA(0, 1), a2 + hstep, voffA);
            PG8_WAIT_V(8); PG8_WAIT_L(0); PG8_BAR; PG8_MMA(0, 0, At, B0); PG8_MMA(0, 1, At, B1); PG8_BAR; PG8_SCHED;
            PG8_LDA(At, 1, 1); PG8_STAGE(PG8_SB(1, 0), b3, voffB); PG8_STAGE(PG8_SB(1, 1), b3 + hstep, voffB); PG8_STAGE(PG8_SA(1, 0), a3, voffA);
            PG8_WAIT_V(8); PG8_WAIT_L(0); PG8_BAR; PG8_MMA(1, 0, At, B0); PG8_MMA(1, 1, At, B1); PG8_BAR; PG8_SCHED;
            } else {
            PG8_LDB(B0, 0, 0); PG8_SCHED; PG8_LDA(At, 0, 0); PG8_STAGE(PG8_SA(1, 1), a1 + hstep, voffA);
            PG8_WAIT_L(8); PG8_BAR; PG8_WAIT_L(0); PG8_MMA(0, 0, At, B0); PG8_BAR; PG8_SCHED;
            PG8_LDB(B1, 0, 1); PG8_STAGE(PG8_SB(0, 0), b2, voffB);
            PG8_BAR; PG8_WAIT_L(0); PG8_MMA(0, 1, At, B1); PG8_BAR;
            PG8_LDA(At, 0, 1); PG8_STAGE(PG8_SA(0, 0), a2, voffA);
            PG8_BAR; PG8_WAIT_L(0); PG8_MMA(1, 0, At, B0); PG8_BAR; PG8_SCHED;
            PG8_STAGE(PG8_SB(0, 1), b2 + hstep, voffB);
            PG8_WAIT_V(6); PG8_BAR; PG8_MMA(1, 1, At, B1); PG8_BAR;
            PG8_LDB(B0, 1, 0); PG8_SCHED; PG8_LDA(At, 1, 0); PG8_STAGE(PG8_SA(0, 1), a2 + hstep, voffA);
            PG8_WAIT_L(8); PG8_BAR; PG8_WAIT_L(0); PG8_MMA(0, 0, At, B0); PG8_BAR; PG8_SCHED;
            PG8_LDB(B1, 1, 1); PG8_STAGE(PG8_SB(1, 0), b3, voffB);
            PG8_BAR; PG8_WAIT_L(0); PG8_MMA(0, 1, At, B1); PG8_BAR;
            PG8_LDA(At, 1, 1); PG8_STAGE(PG8_SA(1, 0), a3, voffA);
            PG8_BAR; PG8_WAIT_L(0); PG8_MMA(1, 0, At, B0); PG8_BAR; PG8_SCHED;
            PG8_STAGE(PG8_SB(1, 1), b3 + hstep, voffB);
            PG8_WAIT_V(6); PG8_BAR; PG8_MMA(1, 1, At, B1); PG8_BAR;
            }
        }
        if constexpr (ALIGN_EPI) { if (wr == 0) PG8_BAR; }
        if constexpr (!Epi::AFTER_DRAIN) { E(acc, cur, wr, wc, fr, fq); S.done(cur); }
        if (!has_next) break;
#pragma unroll
        for (int a = 0; a < 2; ++a)
#pragma unroll
            for (int b = 0; b < 2; ++b)
#pragma unroll
                for (int m = 0; m < 4; ++m)
#pragma unroll
                    for (int n = 0; n < 2; ++n) acc[a][b][m][n] = (f32x4){0.f, 0.f, 0.f, 0.f};
        cur = nxt; cA = nA; cB = nB; ++ui;
        if constexpr (ALIGN_EPI) { if (wr == 1) PG8_BAR; }
    }
    PG8_WAIT_V(0);
    if constexpr (!ALIGN_EPI) { if (wr == 0) PG8_BAR; }
    PG8_BAR;
    if constexpr (Epi::AFTER_DRAIN) { E.fused(acc, cur, wr, wc, fr, fq, lds, wid, lane); S.done(cur); }
#undef PG8_SA
#undef PG8_SB
#undef PG8_STAGE
#undef PG8_LDA
#undef PG8_LDB
#undef PG8_MMA
#undef PG8_WAIT_V
#undef PG8_WAIT_L
#undef PG8_BAR
#undef PG8_SCHED
}
}

#define ST4(ptr, V, O) do { u32x2 w_ = {cvtpk(V[(O) + 0], V[(O) + 1]), cvtpk(V[(O) + 2], V[(O) + 3])}; *(u32x2*)(ptr) = w_; } while (0)
#define PG8_FOREACH(acc, u, F) do {                                                                                   \
    _Pragma("unroll") for (int ai = 0; ai < 2; ++ai) _Pragma("unroll") for (int bj = 0; bj < 2; ++bj) _Pragma("unroll") for (int m = 0; m < 4; ++m) {   \
      const int row_ = (u).pm * 256 + ai * 128 + wr * 64 + m * 16 + fr, c0_ = (u).pn * 256 + bj * 128 + wc * 32 + 8 * fq;   \
      F(acc[ai][bj][m][0], acc[ai][bj][m][1], row_, c0_); SBAR(); } } while (0)

struct EpiG3 {
  static constexpr bool PERM = true, AFTER_DRAIN = false;
  const float* x; float* out; const float* bo;
  __device__ __forceinline__ void blk(const f32x4& a0, const f32x4& a1, int row, int c0) const {
    const f32x4 b0 = *(const f32x4*)(bo + c0), b1 = *(const f32x4*)(bo + c0 + 4);
    const f32x4 x0 = *(const f32x4*)(x + (long)row * DM + c0), x1 = *(const f32x4*)(x + (long)row * DM + c0 + 4);
    *(f32x4*)(out + (long)row * DM + c0) = a0 + b0 + ALPHA * x0;
    *(f32x4*)(out + (long)row * DM + c0 + 4) = a1 + b1 + ALPHA * x1;
  }
  __device__ __forceinline__ void operator()(const f32x4 (&acc)[2][2][4][2], const pg8::Unit& u, int wr, int wc, int fr, int fq) const {
#define G3F(A0, A1, R, C) blk(A0, A1, R, C)
    PG8_FOREACH(acc, u, G3F);
#undef G3F
  }
};
__device__ __forceinline__ void phase_gemm3_new(const Params& p, int g, char* lds, int vid) {
  unsigned char* ws = p.ws;
  EpiG3 E; E.x = p.x[g]; E.out = p.out + (size_t)g * TG * DM; E.bo = p.b_out;
  pg8::Gemm G; G.A = (const bf16_t*)(ws + OFF_XB); G.Bt = (const bf16_t*)(ws + OFF_WOUT); G.M = TG; G.N = 1024; G.K = DM;
  pg8::GroupOrder S; S.xg = vid & 7; S.jl = vid >> 3; S.npn = 4;
  pg8::gemm_phase<EpiG3, pg8::GroupOrder, false, true>((PG8_LAS unsigned char*)lds, G, S, E);
}

struct EpiG1n {
  static constexpr bool PERM = true, AFTER_DRAIN = false;
  bf16_t *U, *CGb, *Qb, *Kb, *Vb, *AGb, *MCb, *MAb; const f32x2* rope; const float* biasv; int seqmask;
  template <int KIND> __device__ __forceinline__ void blk(const f32x4& a0, const f32x4& a1, int row, int c0) const {
    const f32x4 b0 = *(const f32x4*)(biasv + c0), b1 = *(const f32x4*)(biasv + c0 + 4);
    float v[8] = {a0[0] + b0[0], a0[1] + b0[1], a0[2] + b0[2], a0[3] + b0[3], a1[0] + b1[0], a1[1] + b1[1], a1[2] + b1[2], a1[3] + b1[3]};
    if constexpr (KIND == 0 || KIND == 2 || KIND == 3) {
      float w[8];
#pragma unroll
      for (int j = 0; j < 8; ++j) w[j] = __shfl_xor(v[j], 16);
      const int par = (c0 >> 3) & 1, cg = c0 & ~15;
      if constexpr (KIND == 0) {
        if (par == 0) { float o[8];
#pragma unroll
          for (int j = 0; j < 8; ++j) o[j] = v[j] * sigmoidf_(w[j]);
          ST8(U + (long)row * 512 + (cg >> 1), o, 0); }
      } else {
        constexpr bool isq = (KIND == 2); const int j0 = cg - (isq ? 1536 : 2048), b = j0 >> 5, gq = b >> 1, sub = b & 1, d0 = 16 * sub + 8 * ((j0 >> 4) & 1);
        const int pos = row & seqmask;
        const f32x2* cs = rope + (long)pos * 32 + d0;
        const f32x4 c01 = *(const f32x4*)cs, c23 = *(const f32x4*)(cs + 2), c45 = *(const f32x4*)(cs + 4), c67 = *(const f32x4*)(cs + 6);
        const float cc[8] = {c01[0], c01[2], c23[0], c23[2], c45[0], c45[2], c67[0], c67[2]}, sn[8] = {c01[1], c01[3], c23[1], c23[3], c45[1], c45[3], c67[1], c67[3]};
        float o[8]; constexpr float sc = isq ? QSCALE : 1.f; const float sg = par ? 1.f : -1.f;
#pragma unroll
        for (int j = 0; j < 8; ++j) o[j] = (v[j] * cc[j] + sg * (w[j] * sn[j])) * sc;
        ST8((isq ? Qb : Kb) + (long)row * 512 + 64 * gq + d0 + 32 * par, o, 0);
      }
    } else if constexpr (KIND == 1 || KIND == 5) {
      float o[8];
#pragma unroll
      for (int j = 0; j < 8; ++j) o[j] = siluf_(v[j]);
      bf16_t* dp = (KIND == 1) ? (CGb + (long)row * 512 + (c0 - 1024)) : (AGb + (long)row * 512 + (c0 - 3072)); ST8(dp, o, 0);
    } else if constexpr (KIND == 4) {
      ST8(Vb + (long)row * 512 + (c0 - 2560), v, 0);
    } else {
      float o[8];
#pragma unroll
      for (int j = 0; j < 8; ++j) o[j] = sigmoidf_(v[j]);
      bf16_t* dp = (KIND == 6) ? (MCb + (long)row * 1024 + (c0 - 3584)) : (MAb + (long)row * 1024 + (c0 - 4608)); ST8(dp, o, 0);
    }
  }
  template <int KIND> __device__ __forceinline__ void all(const f32x4 (&acc)[2][2][4][2], const pg8::Unit& u, int wr, int wc, int fr, int fq) const {
#define G1F(A0, A1, R, C) blk<KIND>(A0, A1, R, C)
    PG8_FOREACH(acc, u, G1F);
#undef G1F
  }
  __device__ __forceinline__ void operator()(const f32x4 (&acc)[2][2][4][2], const pg8::Unit& u, int wr, int wc, int fr, int fq) const {
    const int pn = u.pn;
    if (pn < 4) all<0>(acc, u, wr, wc, fr, fq);
    else if (pn < 6) all<1>(acc, u, wr, wc, fr, fq);
    else if (pn < 8) all<2>(acc, u, wr, wc, fr, fq);
    else if (pn < 10) all<3>(acc, u, wr, wc, fr, fq);
    else if (pn < 12) all<4>(acc, u, wr, wc, fr, fq);
    else if (pn < 14) all<5>(acc, u, wr, wc, fr, fq);
    else if (pn < 18) all<6>(acc, u, wr, wc, fr, fq);
    else all<7>(acc, u, wr, wc, fr, fq);
  }
};
__device__ __forceinline__ void phase_gemm1_new(const Params& p, int g, char* lds, int vid) {
  unsigned char* ws = p.ws;
  EpiG1n E;
  E.biasv = (const float*)(ws + OFF_BIASV); E.rope = (const f32x2*)(ws + OFF_ROPE);
  E.U = (bf16_t*)(ws + OFF_U); E.CGb = (bf16_t*)(ws + OFF_CG); E.Qb = (bf16_t*)(ws + OFF_Q); E.Kb = (bf16_t*)(ws + OFF_K);
  E.Vb = (bf16_t*)(ws + OFF_V); E.AGb = (bf16_t*)(ws + OFF_AG); E.MCb = (bf16_t*)(ws + OFF_MC); E.MAb = (bf16_t*)(ws + OFF_MA);
  E.seqmask = (g == 0) ? 16383 : 8191;
  pg8::Gemm G; G.A = (g == 0) ? (const bf16_t*)(ws + OFF_XB) : (const bf16_t*)((unsigned char*)p.out + (size_t)TG * DM * 4); G.Bt = (const bf16_t*)(ws + OFF_WIN); G.M = TG; G.N = NV; G.K = DM;
  pg8::GroupOrder S; S.xg = vid & 7; S.jl = vid >> 3; S.npn = 20;
  pg8::gemm_phase<EpiG1n, pg8::GroupOrder, true, true>((PG8_LAS unsigned char*)lds, G, S, E);
  {
    const int tid = otid(), wid = tid >> 6, lane = tid & 63, wr = wid >> 2, wc = wid & 3, r32 = lane & 31, hi = lane >> 5;
    const int xg = vid & 7, jl = vid >> 3;
    G1Ptrs P; P.biasv = E.biasv; P.rope = E.rope; P.U = E.U; P.CGb = E.CGb; P.Qb = E.Qb; P.Kb = E.Kb; P.Vb = E.Vb; P.AGb = E.AGb; P.MCb = E.MCb; P.MAb = E.MAb; P.seqmask = E.seqmask;
    int pm = 8 * xg + (jl & 7); const int n0 = 20 * 256 + 128 * (jl >> 3);
    asm volatile("" : "+s"(pm));
    f32x16 acc1[4][1];
#pragma unroll
    for (int mi = 0; mi < 4; ++mi) acc1[mi][0] = f32x16{};
    gemm_loop<1>(G.A + (long)pm * 256 * DM, DM, G.Bt + (long)n0 * DM, DM, DM / 64, lds, acc1);
    const int row0 = pm * 256 + 128 * wr + r32, vc0 = n0 + 32 * wc + 16 * hi;
    g1_block<7>(acc1[0][0], P, row0, vc0, hi); SBAR();
    g1_block<7>(acc1[1][0], P, row0 + 32, vc0, hi); SBAR();
    g1_block<7>(acc1[2][0], P, row0 + 64, vc0, hi); SBAR();
    g1_block<7>(acc1[3][0], P, row0 + 96, vc0, hi); SBAR();
  }
}

__device__ __forceinline__ void phase_ln(const Params& p, int g) {
  float* out = p.out + (size_t)g * TG * DM;
  const int tid = otid(), wid = tid >> 6, lane = tid & 63;
  for (int row = blockIdx.x * 8 + wid; row < TG; row += gridDim.x * 8) {
    float* rp = out + (long)row * DM;
    f32x4 v[4]; float s = 0.f;
#pragma unroll
    for (int i = 0; i < 4; ++i) { v[i] = *(const f32x4*)(rp + i * 256 + lane * 4); s += (v[i][0] + v[i][1]) + (v[i][2] + v[i][3]); }
#pragma unroll
    for (int m = 1; m < 64; m <<= 1) s += __shfl_xor(s, m);
    const float mean = s * (1.f / 1024.f); float q = 0.f;
#pragma unroll
    for (int i = 0; i < 4; ++i) { v[i] = v[i] - mean; q += (v[i][0] * v[i][0] + v[i][1] * v[i][1]) + (v[i][2] * v[i][2] + v[i][3] * v[i][3]); }
#pragma unroll
    for (int m = 1; m < 64; m <<= 1) q += __shfl_xor(q, m);
    const float rstd = rsqrtf(q * (1.f / 1024.f) + LN_EPS);
#pragma unroll
    for (int i = 0; i < 4; ++i) { f32x4 gg = *(const f32x4*)(p.ln_g + i * 256 + lane * 4), bb = *(const f32x4*)(p.ln_b + i * 256 + lane * 4);
      *(f32x4*)(rp + i * 256 + lane * 4) = v[i] * rstd * gg + bb; }
  }
}

__device__ __forceinline__ void phase_prologue(const Params& p, char* lds) {
  unsigned char* ws = p.ws;
  int bi = 0;
  for (int t = blockIdx.x; t < 1920; t += gridDim.x, ++bi) {
    if (t < 1408) transpose_tile(p, bi, p.w_in, NV, 1024, (bf16_t*)(ws + OFF_WIN), true, t >> 4, t & 15, lds);
    else if (t < 1536) transpose_tile(p, bi, p.w_cp, 1024, 512, (bf16_t*)(ws + OFF_WCP), false, (t - 1408) >> 3, (t - 1408) & 7, lds);
    else if (t < 1664) transpose_tile(p, bi, p.w_ao, 1024, 512, (bf16_t*)(ws + OFF_WAO), false, (t - 1536) >> 3, (t - 1536) & 7, lds);
    else transpose_tile(p, bi, p.w_out, 1024, 1024, (bf16_t*)(ws + OFF_WOUT), false, (t - 1664) >> 4, (t - 1664) & 15, lds);
  }
  for (; bi < 8; ++bi) cvt_batch(p, bi);
  const long gt = (long)blockIdx.x * NTHR + threadIdx.x, gn = (long)gridDim.x * NTHR;
  float* biasv = (float*)(ws + OFF_BIASV);
  for (long i = gt; i < NV; i += gn) biasv[i] = p.b_in[win_actual((int)i)];
  f32x2* rope = (f32x2*)(ws + OFF_ROPE);
  for (long i = gt; i < 16384L * 32; i += gn) { const int pos = (int)(i >> 5), f = (int)(i & 31); const double a = (double)pos * p.inv_freq_pi[f];
    rope[i] = f32x2{(float)cospi(a), (float)sinpi(a)}; }
  if (gt == 0) { float s1 = 0.f, s2 = 0.f; for (int i = 0; i < 64; ++i) { s1 += p.lq1[i] * p.lk1[i]; s2 += p.lq2[i] * p.lk2[i]; }
    *(float*)(ws + OFF_MISC) = expf(s1) - expf(s2) + LAM_INIT; }
}

__device__ __forceinline__ void panel_arrive(unsigned* cnt, bool same_xcd) {
  asm volatile("s_waitcnt vmcnt(0) lgkmcnt(0)" ::: "memory"); __syncthreads();
  if (threadIdx.x == 0) { if (!same_xcd) { __builtin_amdgcn_fence(__ATOMIC_RELEASE, "agent"); asm volatile("s_waitcnt vmcnt(0)" ::: "memory"); }
    __hip_atomic_fetch_add(cnt, 1u, __ATOMIC_RELAXED, __HIP_MEMORY_SCOPE_AGENT); }
}
__device__ __forceinline__ void panel_wait(unsigned* cnt, unsigned want) {
  if (threadIdx.x == 0) { while (__hip_atomic_load(cnt, __ATOMIC_RELAXED, __HIP_MEMORY_SCOPE_AGENT) < want) __builtin_amdgcn_s_sleep(1);
    __builtin_amdgcn_fence(__ATOMIC_ACQUIRE, "agent"); asm volatile("s_waitcnt vmcnt(0)" ::: "memory"); }
  __syncthreads();
}
__device__ __forceinline__ void phase_ln_panel(const Params& p, int g, int vid) {
  float* out = p.out + (size_t)g * TG * DM;
  const int tid = otid(), wid = tid >> 6, lane = tid & 63;
  const int xg = vid & 7, jl = vid >> 3, row0 = (8 * xg + (jl & 7)) * 256 + (jl >> 3) * 64 + wid * 8;
  f32x4 gg[4], bb[4];
#pragma unroll
  for (int k = 0; k < 4; ++k) { gg[k] = *(const f32x4*)(p.ln_g + k * 256 + lane * 4); bb[k] = *(const f32x4*)(p.ln_b + k * 256 + lane * 4); }
#pragma unroll 1
  for (int ib = 0; ib < 8; ib += 4) {
    f32x4 v[4][4];
#pragma unroll
    for (int i = 0; i < 4; ++i)
#pragma unroll
      for (int k = 0; k < 4; ++k) v[i][k] = *(const f32x4*)(out + (long)(row0 + ib + i) * DM + k * 256 + lane * 4);
#pragma unroll
    for (int i = 0; i < 4; ++i) {
      float* rp = out + (long)(row0 + ib + i) * DM;
      float sm = 0.f;
#pragma unroll
      for (int k = 0; k < 4; ++k) sm += (v[i][k][0] + v[i][k][1]) + (v[i][k][2] + v[i][k][3]);
#pragma unroll
      for (int m = 1; m < 64; m <<= 1) sm += __shfl_xor(sm, m);
      const float mean = sm * (1.f / 1024.f); float q = 0.f;
#pragma unroll
      for (int k = 0; k < 4; ++k) { v[i][k] = v[i][k] - mean; q += (v[i][k][0] * v[i][k][0] + v[i][k][1] * v[i][k][1]) + (v[i][k][2] * v[i][k][2] + v[i][k][3] * v[i][k][3]); }
#pragma unroll
      for (int m = 1; m < 64; m <<= 1) q += __shfl_xor(q, m);
      const float rstd = rsqrtf(q * (1.f / 1024.f) + LN_EPS);
#pragma unroll
      for (int k = 0; k < 4; ++k) *(f32x4*)(rp + k * 256 + lane * 4) = v[i][k] * rstd * gg[k] + bb[k];
    }
  }
}

#define LAS __attribute__((address_space(3)))
#define XB_TMO      128
#define XB_XCNT(j)  (256  + 64 * (j))
#define XB_XSUB(j)  (1280 + 64 * (j))
#define XB_XGEN(j)  (2304 + 64 * (j))
#define XB_TOP      3328
#define XB_TOPGEN   3392
#define XCD_BAR_WORDS 3456
#define XB_SPIN_CAP (1u << 18)

__device__ __forceinline__ unsigned xb_ld(unsigned* p)              { return __hip_atomic_load(p, __ATOMIC_RELAXED, __HIP_MEMORY_SCOPE_AGENT); }
__device__ __forceinline__ unsigned xb_add(unsigned* p, unsigned v) { return __hip_atomic_fetch_add(p, v, __ATOMIC_RELAXED, __HIP_MEMORY_SCOPE_AGENT); }
__device__ __forceinline__ unsigned xb_xcc_id() { return (unsigned)__builtin_amdgcn_s_getreg((3 << 11) | 20) & 0xFu; }
#define XB_SPIN(cond, bar) do { unsigned _sp = 0; while (cond) { __builtin_amdgcn_s_sleep(1); \
    if ((++_sp & 255u) == 0u) { if (xb_ld(&(bar)[XB_TMO])) break; if (_sp > XB_SPIN_CAP) { atomicAdd(&(bar)[XB_TMO], 1u); break; } } } } while (0)

struct XcdBarrier {
    unsigned* bar; unsigned x;
    volatile LAS unsigned* st;
};

__device__ __forceinline__ XcdBarrier xcd_barrier_post(unsigned* bar, volatile LAS unsigned* st) {
    XcdBarrier b; b.bar = bar; b.x = xb_xcc_id(); b.st = st;
    if (threadIdx.x == 0) (void)xb_add(&bar[XB_XCNT(b.x)], 1u);
    return b;
}
__device__ __forceinline__ void xcd_barrier_complete(unsigned* bar, unsigned x, unsigned& nloc, unsigned& nx) {
    const unsigned G = gridDim.x * gridDim.y * gridDim.z;
    unsigned sum, cnt, mine, sp = 0u;
    for (;;) {
        sum = 0u; cnt = 0u; mine = 0u;
#pragma unroll
        for (unsigned j = 0; j < 16; ++j) { const unsigned c = xb_ld(&bar[XB_XCNT(j)]); sum += c; cnt += (c > 0u) ? 1u : 0u; mine = (j == x) ? c : mine; }
        if (sum == G) break;
        __builtin_amdgcn_s_sleep(1);
        if ((++sp & 255u) == 0u) { if (xb_ld(&bar[XB_TMO])) break; if (sp > XB_SPIN_CAP) { atomicAdd(&bar[XB_TMO], 1u); break; } }
    }
    nloc = mine > 0u ? mine : 1u; nx = cnt > 0u ? cnt : 1u;
}

__device__ __forceinline__ void xcd_barrier(const XcdBarrier& b) {
    asm volatile("s_waitcnt vmcnt(0)" ::: "memory");
    __syncthreads();
    if (threadIdx.x == 0) {
        unsigned* bar = b.bar;
        __builtin_amdgcn_s_waitcnt(0);
        unsigned nloc = b.st[0], nx = b.st[1];
        if (nloc == 0u) { xcd_barrier_complete(bar, b.x, nloc, nx); b.st[0] = nloc; b.st[1] = nx; }
        const unsigned old = xb_add(&bar[XB_XSUB(b.x)], 1u);
        const unsigned gen = old / nloc;
        if (old + 1u == (gen + 1u) * nloc) {
            __builtin_amdgcn_fence(__ATOMIC_RELEASE, "agent");
            asm volatile("s_waitcnt vmcnt(0)" ::: "memory");
            const unsigned og = xb_add(&bar[XB_TOP], 1u);
            const unsigned tg = og / nx;
            if (og + 1u == (tg + 1u) * nx) xb_add(&bar[XB_TOPGEN], 1u);
            else XB_SPIN(xb_ld(&bar[XB_TOPGEN]) == tg, bar);
            __builtin_amdgcn_fence(__ATOMIC_ACQUIRE, "agent");
            xb_add(&bar[XB_XGEN(b.x)], 1u);
            asm volatile("s_waitcnt vmcnt(0)" ::: "memory");
        } else {
            XB_SPIN(xb_ld(&bar[XB_XGEN(b.x)]) == gen, bar);
            __builtin_amdgcn_fence(__ATOMIC_ACQUIRE, "agent");
            asm volatile("s_waitcnt vmcnt(0)" ::: "memory");
        }
    }
    __syncthreads();
}

__global__ void __launch_bounds__(NTHR, 2) fwd_kernel(Params p) {
  extern __shared__ __attribute__((aligned(16))) char lds[];
#if MULTI_LAUNCH
#define GSYNC() do { } while (0)
#else
  cg::grid_group grid = cg::this_grid();
  unsigned* bar = (unsigned*)(p.ws + OFF_BAR);
  volatile LAS unsigned* xst = (volatile LAS unsigned*)(lds + LDS_BYTES - 32);
  if (threadIdx.x == 0) { xst[0] = 0u; xst[1] = 0u; }
  __syncthreads();
  const XcdBarrier xb = xcd_barrier_post((unsigned*)(p.ws + OFF_XBAR), xst);
#define GSYNC() xcd_barrier(xb)
#endif
  int vid = blockIdx.x; bool same_xcd = false;
#if !MULTI_LAUNCH
  unsigned my_xcc = 0, my_rank = 0;
  if (threadIdx.x == 0) { my_xcc = (unsigned)__builtin_amdgcn_s_getreg((3 << 11) | 20) & 7u; my_rank = __hip_atomic_fetch_add(bar + 8 + my_xcc, 1u, __ATOMIC_RELAXED, __HIP_MEMORY_SCOPE_AGENT); }
#endif
  int ph = 0;
#define PHASE(body) do { if (ph >= p.ph_lo && ph < p.ph_hi) { body; if (ph + 1 < p.ph_hi) GSYNC(); } ++ph; } while (0)
  PHASE(phase_prologue(p, lds));
#if !MULTI_LAUNCH
  {
    int* vsh = (int*)(lds + LDS_BYTES - 16);
    if (threadIdx.x == 0) { bool ok = true; for (int i = 0; i < 8; ++i) ok = ok && (__hip_atomic_load(bar + 8 + i, __ATOMIC_RELAXED, __HIP_MEMORY_SCOPE_AGENT) == 32u);
      const bool use = ok && my_rank < 32u; vsh[0] = use ? (int)(my_xcc + 8u * my_rank) : (int)blockIdx.x; vsh[1] = ok ? 1 : 0; }
    __syncthreads(); vid = __builtin_amdgcn_readfirstlane(vsh[0]); same_xcd = __builtin_amdgcn_readfirstlane(vsh[1]) != 0; __syncthreads();
  }
#endif
  for (int g = 0; g < 2; ++g) {
    PHASE(phase_gemm1_new(p, g, lds, vid));
    PHASE({ phase_conv(p, g, lds); phase_attn(p, g, lds, vid); });
    PHASE({ unsigned* pw = (unsigned*)(p.ws + OFF_BAR); const int pm_ = 8 * (vid & 7) + ((vid >> 3) & 7);
            phase_gemm2(p, lds, vid); panel_arrive(pw + 64 + 64 * g + pm_, same_xcd); panel_wait(pw + 64 + 64 * g + pm_, 4u);
            phase_gemm3_new(p, g, lds, vid); panel_arrive(pw + 192 + 64 * g + pm_, same_xcd); panel_wait(pw + 192 + 64 * g + pm_, 4u);
            phase_ln_panel(p, g, vid); });
  }
}
constexpr int N_PHASES = 7;

extern "C" void kernel_launch(void* const* d_in, const int* in_sizes, int n_in, void* d_out, int out_size, void* d_ws, size_t ws_size, hipStream_t stream) {
  static int grid = 0;
  if (grid == 0) {
    if (n_in != 20 || ws_size < WS_END || out_size != 2 * TG * DM) { fprintf(stderr, "kernel_launch: unexpected shapes n_in %d ws %zu out %d\n", n_in, ws_size, out_size); grid = -1; return; }
    int dev = 0, cus = 0, per_cu = 0;
    hipGetDevice(&dev); hipDeviceGetAttribute(&cus, hipDeviceAttributeMultiprocessorCount, dev);
    if (hipFuncSetAttribute((const void*)fwd_kernel, hipFuncAttributeMaxDynamicSharedMemorySize, LDS_BYTES) != hipSuccess) { fprintf(stderr, "kernel_launch: LDS attribute failed\n"); grid = -1; return; }
    hipOccupancyMaxActiveBlocksPerMultiprocessor(&per_cu, (const void*)fwd_kernel, NTHR, LDS_BYTES);
    if (per_cu < 1) { fprintf(stderr, "kernel_launch: occupancy query says %d\n", per_cu); per_cu = 1; }
    grid = cus;
    if (grid != 256) { fprintf(stderr, "kernel_launch: built for 256 CUs, found %d\n", grid); grid = 256; }
  }
  if (grid < 0) return;
  Params p{};
  p.x[0] = (const float*)d_in[0]; p.x[1] = (const float*)d_in[1];
  p.w_in = (const float*)d_in[2]; p.b_in = (const float*)d_in[3]; p.conv_dw = (const float*)d_in[4]; p.conv_dw_b = (const float*)d_in[5];
  p.conv_ln_g = (const float*)d_in[6]; p.conv_ln_b = (const float*)d_in[7]; p.w_cp = (const float*)d_in[8]; p.b_cp = (const float*)d_in[9];
  p.lq1 = (const float*)d_in[10]; p.lk1 = (const float*)d_in[11]; p.lq2 = (const float*)d_in[12]; p.lk2 = (const float*)d_in[13];
  p.subln_g = (const float*)d_in[14]; p.w_ao = (const float*)d_in[15]; p.w_out = (const float*)d_in[16]; p.b_out = (const float*)d_in[17];
  p.ln_g = (const float*)d_in[18]; p.ln_b = (const float*)d_in[19];
  p.out = (float*)d_out; p.ws = (unsigned char*)d_ws;
  for (int i = 0; i < 32; ++i) p.inv_freq_pi[i] = pow(10000.0, -(double)i / 32.0) / 3.14159265358979323846;
#if MULTI_LAUNCH
  for (int ph = 0; ph < N_PHASES; ++ph) { p.ph_lo = ph; p.ph_hi = ph + 1; hipLaunchKernelGGL(fwd_kernel, dim3(grid), dim3(NTHR), LDS_BYTES, stream, p); }
#else
  p.ph_lo = 0; p.ph_hi = N_PHASES;
  if (hipMemsetAsync((unsigned char*)d_ws + OFF_BAR, 0, 4096 + 16384, stream) != hipSuccess) { fprintf(stderr, "kernel_launch: memset failed\n"); return; }
  void* args[] = {&p};
  hipError_t e = hipLaunchCooperativeKernel((const void*)fwd_kernel, dim3(grid), dim3(NTHR), args, LDS_BYTES, stream);
  if (e != hipSuccess) fprintf(stderr, "kernel_launch: cooperative launch failed: %s\n", hipGetErrorString(e));
#endif
}
```
